# Optimizing an MI355X kernel written in HIP

```python
import math
import jax, jax.numpy as jnp
from jax import lax
import numpy as np


D_MODEL = 1024
BATCH = 16
SEQ = 2048
DEPTH = 2
DEC_BATCH = 128
DEC_SEQ = 1
PAST_LEN = 16384
PAGE_SIZE = 128

N_HEADS = 16
N_KV_HEADS = 2
HEAD_DIM = 64
GROUP = N_HEADS // N_KV_HEADS
WINDOW = 128
BLOCK = WINDOW
W_BUF = min(WINDOW, PAST_LEN)
ROPE_THETA = 10000.0
ATTN_SCALE = HEAD_DIM ** -0.5
GLA_HEADS = 4
GLA_DK = D_MODEL // 2
GLA_DV = D_MODEL
GLA_DKH = GLA_DK // GLA_HEADS
GLA_DVH = GLA_DV // GLA_HEADS
GLA_RANK = 16
GLA_TAU = 16.0
GLA_CHUNK = 64
D_FF = 2816
CONV_W = 3
N_ATTN = (DEPTH + 1) // 2
N_GLA = DEPTH // 2
ALPHA = (2 * DEPTH) ** 0.25
BETA = (8 * DEPTH) ** -0.25
LN_EPS = 1e-5
NORM_EPS = 1e-6
NEG_INF = -1e30

kernel_name = 'swa_sink_gla_convffn_deepnorm_step'


def layer_norm(x, g, b):
    xf = x.astype(jnp.float32)
    mu = jnp.mean(xf, -1, keepdims=True)
    var = jnp.mean(jnp.square(xf - mu), -1, keepdims=True)
    return ((xf - mu) * lax.rsqrt(var + LN_EPS) * g.astype(jnp.float32) + b.astype(jnp.float32)).astype(x.dtype)


def rope(x, pos):
    inv = 1.0 / (ROPE_THETA ** (jnp.arange(0, HEAD_DIM, 2, dtype=jnp.float32) / HEAD_DIM))
    ang = pos[:, None] * inv[None, :]
    cos = jnp.concatenate([jnp.cos(ang), jnp.cos(ang)], -1)[:, None, :]
    sin = jnp.concatenate([jnp.sin(ang), jnp.sin(ang)], -1)[:, None, :]
    xf = x.astype(jnp.float32)
    x1, x2 = jnp.split(xf, 2, axis=-1)
    rot = jnp.concatenate([-x2, x1], -1)
    return (xf * cos + rot * sin).astype(x.dtype)


def sink_softmax(scores, mask, sink):
    s = jnp.where(mask, scores, NEG_INF)
    m = jnp.maximum(jnp.max(s, -1, keepdims=True), sink)
    p = jnp.exp(s - m)
    return p / (jnp.sum(p, -1, keepdims=True) + jnp.exp(sink - m))


def qkv_proj(x, w_qkv, b_qkv, offset):
    B, T, _ = x.shape
    nq = N_HEADS * HEAD_DIM
    nk = N_KV_HEADS * HEAD_DIM
    qkv = x @ w_qkv + b_qkv
    q = qkv[..., :nq].reshape(B, T, N_HEADS, HEAD_DIM)
    k = qkv[..., nq:nq + nk].reshape(B, T, N_KV_HEADS, HEAD_DIM)
    v = qkv[..., nq + nk:].reshape(B, T, N_KV_HEADS, HEAD_DIM)
    pos = jnp.arange(T, dtype=jnp.float32) + offset
    return rope(q, pos), rope(k, pos), v


def swa_prompt(x, w_qkv, b_qkv, sinks, w_o):
    B, T, _ = x.shape
    q, k, v = qkv_proj(x, w_qkv, b_qkv, 0)
    nb = T // BLOCK
    qb = q.reshape(B, nb, BLOCK, N_KV_HEADS, GROUP, HEAD_DIM)
    kb = k.reshape(B, nb, BLOCK, N_KV_HEADS, HEAD_DIM)
    vb = v.reshape(B, nb, BLOCK, N_KV_HEADS, HEAD_DIM)

    def with_prev(t):
        prev = jnp.pad(t, ((0, 0), (1, 0), (0, 0), (0, 0), (0, 0)))[:, :nb]
        return jnp.concatenate([prev, t], axis=2)

    kk, vv = with_prev(kb), with_prev(vb)
    scores = jnp.einsum('bnqkgd,bnskd->bnkgqs', qb, kk).astype(jnp.float32) * ATTN_SCALE
    blk = jnp.arange(nb)[:, None, None]
    qpos = blk * BLOCK + jnp.arange(BLOCK)[None, :, None]
    kpos = (blk - 1) * BLOCK + jnp.arange(2 * BLOCK)[None, None, :]
    mask = (kpos >= 0) & (kpos <= qpos) & (qpos - kpos < WINDOW)
    sink = sinks.astype(jnp.float32).reshape(N_KV_HEADS, GROUP)[None, None, :, :, None, None]
    probs = sink_softmax(scores, mask[None, :, None, None], sink).astype(v.dtype)
    o = jnp.einsum('bnkgqs,bnskd->bnqkgd', probs, vv).reshape(B, T, N_HEADS * HEAD_DIM)
    return o @ w_o, k[:, T - W_BUF:], v[:, T - W_BUF:]


def swa_sample(x, k_buf, v_buf, w_qkv, b_qkv, sinks, w_o):
    B, T, _ = x.shape
    q, k, v = qkv_proj(x, w_qkv, b_qkv, PAST_LEN)
    kk = jnp.concatenate([k_buf.astype(k.dtype), k], axis=1)
    vv = jnp.concatenate([v_buf.astype(v.dtype), v], axis=1)
    qpos = PAST_LEN + jnp.arange(T)
    kpos = PAST_LEN - W_BUF + jnp.arange(W_BUF + T)
    mask = (kpos[None, :] <= qpos[:, None]) & (qpos[:, None] - kpos[None, :] < WINDOW)
    qg = q.reshape(B, T, N_KV_HEADS, GROUP, HEAD_DIM)
    scores = jnp.einsum('btkgd,bskd->bkgts', qg, kk).astype(jnp.float32) * ATTN_SCALE
    sink = sinks.astype(jnp.float32).reshape(N_KV_HEADS, GROUP)[None, :, :, None, None]
    probs = sink_softmax(scores, mask, sink).astype(v.dtype)
    o = jnp.einsum('bkgts,bskd->btkgd', probs, vv).reshape(B, T, N_HEADS * HEAD_DIM)
    return o @ w_o, kk[:, -W_BUF:], vv[:, -W_BUF:]


def gla_recurrence(q, k, v, log_a, s0, chunk):
    B, T, H, DK = q.shape
    DV = v.shape[-1]
    nc = T // chunk

    def to_chunks(t):
        return t.astype(jnp.float32).reshape(B, nc, chunk, H, t.shape[-1]).transpose(1, 0, 3, 2, 4)

    causal = jnp.tril(jnp.ones((chunk, chunk), dtype=bool))

    def step(S, inp):
        qc, kc, vc, lc = inp
        b = jnp.cumsum(lc, axis=2)
        b_last = b[:, :, -1:, :]
        q_in = qc * jnp.exp(b)
        k_in = kc * jnp.exp(-b)
        att = jnp.where(causal, jnp.einsum('bhtd,bhsd->bhts', q_in, k_in), 0.0)
        o = jnp.einsum('bhts,bhsv->bhtv', att, vc) + jnp.einsum('bhtd,bhdv->bhtv', q_in, S)
        S_new = jnp.exp(b_last[:, :, 0, :, None]) * S + jnp.einsum('bhsd,bhsv->bhdv', kc * jnp.exp(b_last - b), vc)
        return S_new, o

    S, o = lax.scan(step, s0.astype(jnp.float32), (to_chunks(q), to_chunks(k), to_chunks(v), to_chunks(log_a)))
    o = o.transpose(1, 0, 3, 2, 4).reshape(B, T, H, DV)
    return o, S


def gla_mix(x, s0, w_in, w_a1, w_a2, b_a, norm_g, w_o):
    B, T, _ = x.shape
    proj = x @ w_in
    q = proj[..., :GLA_DK].reshape(B, T, GLA_HEADS, GLA_DKH) * (GLA_DKH ** -0.5)
    k = proj[..., GLA_DK:2 * GLA_DK].reshape(B, T, GLA_HEADS, GLA_DKH)
    v = proj[..., 2 * GLA_DK:2 * GLA_DK + GLA_DV].reshape(B, T, GLA_HEADS, GLA_DVH)
    g = proj[..., 2 * GLA_DK + GLA_DV:].reshape(B, T, GLA_HEADS, GLA_DVH)
    log_a = jax.nn.log_sigmoid(((x @ w_a1) @ w_a2 + b_a).astype(jnp.float32)) / GLA_TAU
    log_a = log_a.reshape(B, T, GLA_HEADS, GLA_DKH)
    o, s_new = gla_recurrence(q, k, v, log_a, s0, min(GLA_CHUNK, T))
    o = o * lax.rsqrt(jnp.mean(jnp.square(o), -1, keepdims=True) + NORM_EPS) * norm_g.astype(jnp.float32)
    o = (o * jax.nn.silu(g.astype(jnp.float32))).astype(x.dtype).reshape(B, T, GLA_DV)
    return o @ w_o, s_new.astype(s0.dtype)


def conv_ffn(x, buf, w_up, conv_w, conv_b, w_down):
    T = x.shape[1]
    h = x @ w_up
    a, u = h[..., :D_FF], h[..., D_FF:]
    ap = jnp.concatenate([buf.astype(a.dtype), a], axis=1)
    c = conv_b + sum(conv_w[j] * ap[:, j:j + T] for j in range(CONV_W))
    y = (jax.nn.gelu(c, approximate=False) * u) @ w_down
    return y, ap[:, T:]


def setup_inputs(seed: int = 0) -> dict:
    key = jax.random.key(seed)
    ks = jax.random.split(key, 26)

    def nrm(k, shape, scale):
        return jax.random.normal(k, shape, jnp.float32) * scale

    qkv_w = (N_HEADS + 2 * N_KV_HEADS) * HEAD_DIM
    gla_in = 2 * GLA_DK + 2 * GLA_DV
    return {
        'x_prompt': nrm(ks[0], (BATCH, SEQ, D_MODEL), 1.0),
        'x_sample': nrm(ks[1], (DEC_BATCH, DEC_SEQ, D_MODEL), 1.0),
        'cache_k': nrm(ks[2], (N_ATTN, DEC_BATCH, W_BUF, N_KV_HEADS, HEAD_DIM), 1.0),
        'cache_v': nrm(ks[3], (N_ATTN, DEC_BATCH, W_BUF, N_KV_HEADS, HEAD_DIM), 1.0),
        'state_gla': nrm(ks[4], (N_GLA, DEC_BATCH, GLA_HEADS, GLA_DKH, GLA_DVH), 1.0),
        'state_conv': nrm(ks[5], (DEPTH, DEC_BATCH, CONV_W - 1, D_FF), 1.0),
        'attn_w_qkv': nrm(ks[6], (N_ATTN, D_MODEL, qkv_w), D_MODEL ** -0.5),
        'attn_b_qkv': nrm(ks[7], (N_ATTN, qkv_w), 0.02),
        'attn_sinks': nrm(ks[8], (N_ATTN, N_HEADS), 1.0),
        'attn_w_o': nrm(ks[9], (N_ATTN, N_HEADS * HEAD_DIM, D_MODEL), BETA * (N_HEADS * HEAD_DIM) ** -0.5),
        'gla_w_in': nrm(ks[10], (N_GLA, D_MODEL, gla_in), D_MODEL ** -0.5),
        'gla_w_a1': nrm(ks[11], (N_GLA, D_MODEL, GLA_RANK), D_MODEL ** -0.5),
        'gla_w_a2': nrm(ks[12], (N_GLA, GLA_RANK, GLA_DK), GLA_RANK ** -0.5),
        'gla_b_a': nrm(ks[13], (N_GLA, GLA_DK), 0.1),
        'gla_norm_g': 1.0 + nrm(ks[14], (N_GLA, GLA_DVH), 0.02),
        'gla_w_o': nrm(ks[15], (N_GLA, GLA_DV, D_MODEL), BETA * GLA_DV ** -0.5),
        'ffn_w_up': nrm(ks[16], (DEPTH, D_MODEL, 2 * D_FF), D_MODEL ** -0.5),
        'ffn_conv_w': nrm(ks[17], (DEPTH, CONV_W, D_FF), CONV_W ** -0.5),
        'ffn_conv_b': nrm(ks[18], (DEPTH, D_FF), 0.02),
        'ffn_w_down': nrm(ks[19], (DEPTH, D_FF, D_MODEL), BETA * D_FF ** -0.5),
        'ln_mix_g': 1.0 + nrm(ks[20], (DEPTH, D_MODEL), 0.02),
        'ln_mix_b': nrm(ks[21], (DEPTH, D_MODEL), 0.02),
        'ln_ffn_g': 1.0 + nrm(ks[22], (DEPTH, D_MODEL), 0.02),
        'ln_ffn_b': nrm(ks[23], (DEPTH, D_MODEL), 0.02),
    }


def reference(x_prompt, x_sample, cache_k, cache_v, state_gla, state_conv,
              attn_w_qkv, attn_b_qkv, attn_sinks, attn_w_o,
              gla_w_in, gla_w_a1, gla_w_a2, gla_b_a, gla_norm_g, gla_w_o,
              ffn_w_up, ffn_conv_w, ffn_conv_b, ffn_w_down,
              ln_mix_g, ln_mix_b, ln_ffn_g, ln_ffn_b):
    xp, xs = x_prompt, x_sample
    kp_l, vp_l, ks_l, vs_l = [], [], [], []
    sp_l, ss_l, cp_l, cs_l = [], [], [], []
    for i in range(DEPTH):
        j = i // 2
        if i % 2 == 0:
            mp, kp, vp = swa_prompt(xp, attn_w_qkv[j], attn_b_qkv[j], attn_sinks[j], attn_w_o[j])
            ms, k_s, v_s = swa_sample(xs, cache_k[j], cache_v[j], attn_w_qkv[j], attn_b_qkv[j], attn_sinks[j], attn_w_o[j])
            kp_l.append(kp)
            vp_l.append(vp)
            ks_l.append(k_s)
            vs_l.append(v_s)
        else:
            s0 = jnp.zeros((xp.shape[0], GLA_HEADS, GLA_DKH, GLA_DVH), state_gla.dtype)
            mp, sp = gla_mix(xp, s0, gla_w_in[j], gla_w_a1[j], gla_w_a2[j], gla_b_a[j], gla_norm_g[j], gla_w_o[j])
            ms, ss = gla_mix(xs, state_gla[j], gla_w_in[j], gla_w_a1[j], gla_w_a2[j], gla_b_a[j], gla_norm_g[j], gla_w_o[j])
            sp_l.append(sp)
            ss_l.append(ss)
        xp = layer_norm(ALPHA * xp + mp, ln_mix_g[i], ln_mix_b[i])
        xs = layer_norm(ALPHA * xs + ms, ln_mix_g[i], ln_mix_b[i])
        buf0 = jnp.zeros((xp.shape[0], CONV_W - 1, D_FF), state_conv.dtype)
        fp, cp = conv_ffn(xp, buf0, ffn_w_up[i], ffn_conv_w[i], ffn_conv_b[i], ffn_w_down[i])
        fs, cs = conv_ffn(xs, state_conv[i], ffn_w_up[i], ffn_conv_w[i], ffn_conv_b[i], ffn_w_down[i])
        cp_l.append(cp)
        cs_l.append(cs)
        xp = layer_norm(ALPHA * xp + fp, ln_ffn_g[i], ln_ffn_b[i])
        xs = layer_norm(ALPHA * xs + fs, ln_ffn_g[i], ln_ffn_b[i])
    return (xp, xs, jnp.stack(kp_l), jnp.stack(vp_l), jnp.stack(ks_l), jnp.stack(vs_l),
            jnp.stack(sp_l), jnp.stack(ss_l), jnp.stack(cp_l), jnp.stack(cs_l))
```

```cpp
#include <hip/hip_runtime.h>
#include <hip/hip_cooperative_groups.h>
#include <cstdio>
#include <cstdint>
namespace cg = cooperative_groups;

#ifndef MK_PER_PHASE
#define MK_PER_PHASE 0
#endif

constexpr int DM = 1024, NBATCH = 16, SEQ = 2048, MP = NBATCH * SEQ, NS = 128;
constexpr int SROW = 33024;
constexpr int MROWS = 33280;
constexpr int NQKV = 1280, FF = 2816, NUP = 2 * FF, NPROJ = 3072, NGIN = 3584;
constexpr float ALPHA = 1.41421356237f, LN_EPS = 1e-5f, QS_GLA = 0.08838834764831845f;
constexpr size_t O_Y = 0, O_YS = 33554432, O_KP = 33685504, O_VP = 33947648, O_KS = 34209792, O_VS = 36306944, O_GP = 38404096, O_GS = 40501248, O_CP = 57278464, O_CS = 57458688;
constexpr size_t MiB = 1u << 20;
constexpr size_t WS_ROPE = 1 * MiB;
constexpr size_t WS_WQKV = 2 * MiB;
constexpr size_t WS_WO = WS_WQKV + 2621440;
constexpr size_t WS_WUP = WS_WO + 2 * MiB;
constexpr size_t WS_WDN = WS_WUP + 22 * MiB;
constexpr size_t WS_WGIN = WS_WDN + 11 * MiB;
constexpr size_t WS_WGO = WS_WGIN + 7 * MiB;
constexpr size_t WS_XN = 50 * MiB;
constexpr size_t WS_SSQ = 116 * MiB;
constexpr size_t WS_R1 = 119 * MiB;
constexpr size_t WS_LA = WS_R1 + (size_t)MROWS * NPROJ * 2;
constexpr size_t WS_END = WS_LA + (size_t)MROWS * 512 * 4;
static_assert(WS_WGO + 2 * MiB <= WS_XN && WS_XN + (size_t)(MROWS + 8) * DM * 2 <= WS_SSQ && WS_SSQ + (size_t)MROWS * 64 <= WS_R1 && WS_END <= 512 * MiB, "ws map");

constexpr int LDS_BYTES = 147456;

#define LAS __attribute__((address_space(3)))
typedef unsigned short bf16_t;
typedef short bf16x8 __attribute__((ext_vector_type(8)));
typedef float f32x4 __attribute__((ext_vector_type(4)));
typedef float f32x2 __attribute__((ext_vector_type(2)));
typedef unsigned u32x4 __attribute__((ext_vector_type(4)));
typedef unsigned u32x2 __attribute__((ext_vector_type(2)));

typedef __bf16 bf16x2_t __attribute__((ext_vector_type(2)));
__device__ __forceinline__ unsigned cvt_pk_bf16(float lo, float hi) { const f32x2 v = {lo, hi}; return __builtin_bit_cast(unsigned, __builtin_convertvector(v, bf16x2_t)); }
__device__ __forceinline__ float bflo(unsigned w) { return __uint_as_float(w << 16); }
__device__ __forceinline__ float bfhi(unsigned w) { return __uint_as_float(w & 0xffff0000u); }
__device__ __forceinline__ float bf2f(bf16_t h) { return __uint_as_float((unsigned)h << 16); }
__device__ __forceinline__ bf16_t f2bf(float f) { return (bf16_t)(cvt_pk_bf16(f, 0.f) & 0xffffu); }
__device__ __forceinline__ bf16x8 mk8(unsigned a, unsigned b, unsigned c, unsigned d) { u32x4 v = {a, b, c, d}; return __builtin_bit_cast(bf16x8, v); }
__device__ __forceinline__ f32x4 mfma16(bf16x8 a, bf16x8 b, f32x4 c) { return __builtin_amdgcn_mfma_f32_16x16x32_bf16(a, b, c, 0, 0, 0); }
__device__ __forceinline__ bool row_valid(int r) { return r < MP || (r >= SROW && r < SROW + NS); }
__device__ __forceinline__ size_t xy_off(int r) { return (size_t)(r < MP ? r : r - (SROW - MP)) * DM; }

namespace pg8 {
#define PG8_LAS __attribute__((address_space(3)))
constexpr int BM = 256, BK = 64, HALF = 128, HTB = HALF * BK * 2, STAGE_BYTES = 8 * HTB, NXCD = 8, WGM = 8;
__host__ __device__ __forceinline__ int lds_byte(int r, int c) { const int st = (r >> 4) * 2 + (c >> 5), rr = r & 15, cc = c & 31, ob = rr * 64 + cc * 2; return st * 1024 + (ob ^ (((ob >> 9) & 1) << 5)); }
__host__ __device__ __forceinline__ void stage_rc(int b, int& R, int& C) { const int st = b / 1024, sb = b % 1024, swz = sb ^ (((sb >> 9) & 1) << 5); R = (st >> 1) * 16 + swz / 64; C = (st & 1) * 32 + (swz % 64) / 2; }
__host__ __device__ __forceinline__ int perm32(int rho) { const int n = rho >> 4, i = rho & 15; return 8 * (i >> 2) + 4 * n + (i & 3); }

struct Unit { int pm, pn; };
struct Gemm { const bf16_t* A; const bf16_t* Bt; int N, K, nM, mode; };
__device__ __forceinline__ int tile_row0(int pm) { return 256 * (pm < 128 ? pm : 129); }
__device__ __forceinline__ int tile_base1(int pm) { return pm < 133 ? 248 * pm : SROW; }
__device__ __forceinline__ const char* abase(const Gemm& g, int pm) {
    const long row = g.mode ? (long)tile_base1(pm) - 2 : (long)tile_row0(pm);
    return (const char*)g.A + row * (long)g.K * 2;
}

struct StaticOrder {
    int nM, nN, nwg, G, c;
    __host__ __device__ void init(int nM_, int N, int G_, int c_) { nM = nM_; nN = N / BM; nwg = nM * nN; G = G_; c = c_; }
    __host__ __device__ bool next(int i, Unit& u) const {
        const long L = (long)i * G + c; if (L >= nwg) return false;
        int wgid = (int)L; { const int q = nwg / NXCD, r = nwg % NXCD, xcd = wgid % NXCD, off = wgid / NXCD; wgid = (xcd < r ? xcd * (q + 1) : r * (q + 1) + (xcd - r) * q) + off; }
        const int nig = WGM * nN, gid = wgid / nig, fm = gid * WGM, gsz = (nM - fm) < WGM ? (nM - fm) : WGM;
        u.pm = fm + ((wgid % nig) % gsz); u.pn = (wgid % nig) / gsz; return true;
    }
    __device__ __forceinline__ void a_ready(const Unit&) const {}
    __device__ __forceinline__ void done(const Unit&) const {}
};

__device__ __forceinline__ f32x2 gelu_pk(f32x2 v) {
    const f32x2 av = __builtin_elementwise_abs(v), d = av * 0.2316418882f + 1.0f;
    f32x2 t; t.x = __builtin_amdgcn_rcpf(d.x); t.y = __builtin_amdgcn_rcpf(d.y);
    f32x2 q = t * 0.5307027145f + (-0.7265760135f); q = q * t + 0.7107068705f; q = q * t + (-0.142248368f); q = q * t + 0.127414796f; q = q * t;
    const f32x2 s = (v * v) * (-0.72134752044f);
    f32x2 e; e.x = __builtin_amdgcn_exp2f(s.x); e.y = __builtin_amdgcn_exp2f(s.y);
    const f32x2 m = v * (q * e), r = v - m;
    f32x2 o; o.x = v.x < 0.f ? m.x : r.x; o.y = v.y < 0.f ? m.y : r.y; return o;
}

struct EpiBf16Bias {
    static constexpr bool PERM = true, AFTER_DRAIN = false;
    bf16_t* O; int ldc; const float* bias;
    __device__ __forceinline__ void operator()(const f32x4 (&acc)[2][2][4][2], const Unit& u, int wr, int wc, int fr, int fq) const {
        const int row0 = tile_row0(u.pm) + wr * 64 + fr, col0 = u.pn * BM + wc * 32 + 8 * fq;
        f32x4 bv[2][2];
#pragma unroll
        for (int bj = 0; bj < 2; ++bj)
#pragma unroll
            for (int n = 0; n < 2; ++n) bv[bj][n] = *(const f32x4*)(bias + col0 + bj * HALF + 4 * n);
#pragma unroll
        for (int ai = 0; ai < 2; ++ai)
#pragma unroll
            for (int m = 0; m < 4; ++m) { bf16_t* rowp = O + (size_t)(row0 + ai * HALF + m * 16) * ldc + col0;
#pragma unroll
                for (int bj = 0; bj < 2; ++bj) { const f32x4 v0 = acc[ai][bj][m][0] + bv[bj][0], v1 = acc[ai][bj][m][1] + bv[bj][1];
                    u32x4 w; w.x = cvt_pk_bf16(v0[0], v0[1]); w.y = cvt_pk_bf16(v0[2], v0[3]); w.z = cvt_pk_bf16(v1[0], v1[1]); w.w = cvt_pk_bf16(v1[2], v1[3]);
                    *(u32x4*)(rowp + bj * HALF) = w; } }
    }
};
struct EpiRes {
    static constexpr bool PERM = true, AFTER_DRAIN = false;
    const float* resP; const float* resS; float* out;
    __device__ __forceinline__ void operator()(const f32x4 (&acc)[2][2][4][2], const Unit& u, int wr, int wc, int fr, int fq) const {
        const int rb = tile_row0(u.pm) + wr * 64 + fr, col0 = u.pn * BM + wc * 32 + 8 * fq;
#pragma unroll
        for (int ai = 0; ai < 2; ++ai)
#pragma unroll
            for (int m = 0; m < 4; ++m) { const int r = rb + ai * HALF + m * 16;
                if (row_valid(r)) {
                    const float* rp = (r < MP ? resP + (size_t)r * DM : resS + (size_t)(r - SROW) * DM) + col0; float* op = out + xy_off(r) + col0;
#pragma unroll
                    for (int bj = 0; bj < 2; ++bj) { const f32x4 x0 = *(const f32x4*)(rp + bj * HALF), x1 = *(const f32x4*)(rp + bj * HALF + 4);
                        *(f32x4*)(op + bj * HALF) = x0 * ALPHA + acc[ai][bj][m][0]; *(f32x4*)(op + bj * HALF + 4) = x1 * ALPHA + acc[ai][bj][m][1]; } } }
    }
};
struct EpiGlaIn {
    static constexpr bool PERM = true, AFTER_DRAIN = false;
    bf16_t* P; float* LA; const float* ba;
    __device__ __forceinline__ void operator()(const f32x4 (&acc)[2][2][4][2], const Unit& u, int wr, int wc, int fr, int fq) const {
        const int row0 = tile_row0(u.pm) + wr * 64 + fr;
        if (u.pn < 12) {
            const int col0 = u.pn * BM + wc * 32 + 8 * fq;
#pragma unroll
            for (int ai = 0; ai < 2; ++ai)
#pragma unroll
                for (int m = 0; m < 4; ++m) { bf16_t* rowp = P + (size_t)(row0 + ai * HALF + m * 16) * NPROJ + col0;
#pragma unroll
                    for (int bj = 0; bj < 2; ++bj) { const f32x4 v0 = acc[ai][bj][m][0], v1 = acc[ai][bj][m][1];
                        u32x4 w; w.x = cvt_pk_bf16(v0[0], v0[1]); w.y = cvt_pk_bf16(v0[2], v0[3]); w.z = cvt_pk_bf16(v1[0], v1[1]); w.w = cvt_pk_bf16(v1[2], v1[3]);
                        *(u32x4*)(rowp + bj * HALF) = w; } }
        } else {
            const int col0 = (u.pn - 12) * BM + wc * 32 + 8 * fq;
#pragma unroll
            for (int bj = 0; bj < 2; ++bj)
#pragma unroll
                for (int n = 0; n < 2; ++n) { const f32x4 bv = *(const f32x4*)(ba + col0 + bj * HALF + 4 * n);
#pragma unroll
                    for (int ai = 0; ai < 2; ++ai)
#pragma unroll
                        for (int m = 0; m < 4; ++m) { const f32x4 z = acc[ai][bj][m][n] + bv; f32x4 o;
#pragma unroll
                            for (int e = 0; e < 4; ++e) o[e] = -(fmaxf(-z[e], 0.f) + log1pf(__expf(-fabsf(z[e])))) * 0.0625f;
                            *(f32x4*)(LA + (size_t)(row0 + ai * HALF + m * 16) * 512 + col0 + bj * HALF + 4 * n) = o; } }
        }
    }
};
__device__ __forceinline__ float dpp_ror1(float v) { return __int_as_float(__builtin_amdgcn_update_dpp(0, __float_as_int(v), 0x121, 0xf, 0xf, false)); }
__device__ __forceinline__ float dpp_ror2(float v) { return __int_as_float(__builtin_amdgcn_update_dpp(0, __float_as_int(v), 0x122, 0xf, 0xf, false)); }
struct EpiUp {
    static constexpr bool PERM = true, AFTER_DRAIN = false;
    bf16_t* G; const float* cw; const float* cb; const float* sconv; float* ocp; float* ocs;
    __device__ __forceinline__ void operator()(const f32x4 (&acc)[2][2][4][2], const Unit& u, int wr, int wc, int fr, int fq) const {
        const int B = tile_base1(u.pm); const bool samp = (u.pm >= 133);
#pragma unroll
        for (int n = 0; n < 2; ++n) {
            const int f = u.pn * HALF + wc * 32 + 8 * fq + 4 * n;
            const f32x4 w0 = *(const f32x4*)(cw + f), w1 = *(const f32x4*)(cw + FF + f), w2 = *(const f32x4*)(cw + 2 * FF + f), bb = *(const f32x4*)(cb + f);
#pragma unroll
            for (int ai = 0; ai < 2; ++ai) {
                const int seg = 2 * ai + wr;
                f32x4 p1 = {0.f, 0.f, 0.f, 0.f}, p2 = {0.f, 0.f, 0.f, 0.f};
#pragma unroll
                for (int m = 0; m < 4; ++m) {
                    const f32x4 a = acc[ai][0][m][n], uu = acc[ai][1][m][n];
                    f32x4 a1, a2;
#pragma unroll
                    for (int e = 0; e < 4; ++e) { a1[e] = dpp_ror1(a[e]); a2[e] = dpp_ror2(a[e]); }
                    f32x4 s1, s2;
#pragma unroll
                    for (int e = 0; e < 4; ++e) { s1[e] = fr >= 1 ? a1[e] : p1[e]; s2[e] = fr >= 2 ? a2[e] : p2[e]; }
                    p1 = a1; p2 = a2;
                    const int j = 16 * m + fr, r = B + 62 * seg + j - 2;
                    bool doit;
                    if (!samp) {
                        doit = (j >= 2) && (r < MP);
                        const int tt = r & (SEQ - 1);
                        if (tt < 1) s1 = (f32x4){0.f, 0.f, 0.f, 0.f};
                        if (tt < 2) s2 = (f32x4){0.f, 0.f, 0.f, 0.f};
                        if (doit && tt >= SEQ - 2) *(f32x4*)(ocp + ((size_t)(r >> 11) * 2 + (tt - (SEQ - 2))) * FF + f) = a;
                    } else {
                        doit = (j >= 2) && (r < SROW + NS);
                        if (doit) { const int bs = r - SROW;
                            s2 = *(const f32x4*)(sconv + ((size_t)bs * 2 + 0) * FF + f); s1 = *(const f32x4*)(sconv + ((size_t)bs * 2 + 1) * FF + f);
                            *(f32x4*)(ocs + ((size_t)bs * 2 + 0) * FF + f) = s1; *(f32x4*)(ocs + ((size_t)bs * 2 + 1) * FF + f) = a; }
                    }
                    if (doit) {
                        const f32x4 c = bb + w0 * s2 + w1 * s1 + w2 * a;
                        const f32x2 g0 = gelu_pk((f32x2){c[0], c[1]}), g1 = gelu_pk((f32x2){c[2], c[3]});
                        u32x2 w; w.x = cvt_pk_bf16(g0.x * uu[0], g0.y * uu[1]); w.y = cvt_pk_bf16(g1.x * uu[2], g1.y * uu[3]);
                        *(u32x2*)(G + (size_t)r * FF + f) = w;
                    }
                }
            }
        }
    }
};

template <class Epi, class Sched, bool ALIGN_EPI = false, bool SP2 = false>
__device__ __forceinline__ void gemm_phase(PG8_LAS unsigned char* lds, const Gemm g, const Sched& S, const Epi& E) {
    const int tid = threadIdx.x, wid = __builtin_amdgcn_readfirstlane(tid >> 6), lane = tid & 63, wr = wid >> 2, wc = wid & 3, fr = lane & 15, fq = lane >> 4;
    const int K = g.K, nt = K / BK;
    unsigned voffA[2], voffB[2];
#pragma unroll
    for (int i = 0; i < 2; ++i) { int R, C; stage_rc(tid * 16 + i * 8192, R, C); const int Rb = Epi::PERM ? ((R & ~31) + perm32(R & 31)) : R;
        voffA[i] = (unsigned)((g.mode ? (R - 2 * (R >> 6)) : R) * K + C) * 2u; voffB[i] = (unsigned)(Rb * K + C) * 2u; }
    const size_t kstep = (size_t)(BK * 2);
    const size_t hstep = (size_t)HALF * K * 2;
    const size_t tstep = 2 * hstep; const size_t hsA = g.mode ? (size_t)124 * K * 2 : hstep;
    const unsigned ldsw = (unsigned)wid * 1024u;
    const int aoff = lds_byte(wr * 64 + fr, fq * 8), boff = lds_byte(wc * 32 + fr, fq * 8);
#define PG8_SA(b, h) (((b) * 2 + (h)) * HTB)
#define PG8_SB(b, h) ((4 + (b) * 2 + (h)) * HTB)
#define PG8_STAGE(bufoff, gbase, voff) do { _Pragma("unroll") for (int _i = 0; _i < 2; ++_i) \
        __builtin_amdgcn_global_load_lds((const unsigned*)((const char*)(gbase) + (voff)[_i]), (PG8_LAS unsigned*)(lds + (bufoff) + ldsw + _i * 8192), 16, 0, 0); } while (0)
#define PG8_LDA(dst, b, h) do { _Pragma("unroll") for (int m = 0; m < 4; ++m) _Pragma("unroll") for (int k = 0; k < 2; ++k) dst[m][k] = *(const PG8_LAS bf16x8*)(lds + PG8_SA(b, h) + aoff + m * 2048 + k * 1024); } while (0)
#define PG8_LDB(dst, b, h) do { _Pragma("unroll") for (int n = 0; n < 2; ++n) _Pragma("unroll") for (int k = 0; k < 2; ++k) dst[n][k] = *(const PG8_LAS bf16x8*)(lds + PG8_SB(b, h) + boff + n * 2048 + k * 1024); } while (0)
#define PG8_MMA(ai, bj, At, Bt) do { __builtin_amdgcn_s_setprio(1); _Pragma("unroll") for (int m = 0; m < 4; ++m) _Pragma("unroll") for (int n = 0; n < 2; ++n) _Pragma("unroll") for (int k = 0; k < 2; ++k) \
        acc[ai][bj][m][n] = __builtin_amdgcn_mfma_f32_16x16x32_bf16(Bt[n][k], At[m][k], acc[ai][bj][m][n], 0, 0, 0); __builtin_amdgcn_s_setprio(0); } while (0)
#define PG8_WAIT_V(n) asm volatile("s_waitcnt vmcnt(" #n ")" ::: "memory")
#define PG8_WAIT_L(n) asm volatile("s_waitcnt lgkmcnt(" #n ")" ::: "memory")
#define PG8_BAR __builtin_amdgcn_s_barrier()
#define PG8_SCHED __builtin_amdgcn_sched_barrier(0)
    Unit cur, nxt; int ui = 0;
    if (!S.next(0, cur)) return;
    f32x4 acc[2][2][4][2];
#pragma unroll
    for (int a = 0; a < 2; ++a)
#pragma unroll
        for (int b = 0; b < 2; ++b)
#pragma unroll
            for (int m = 0; m < 4; ++m)
#pragma unroll
                for (int n = 0; n < 2; ++n) acc[a][b][m][n] = (f32x4){0.f, 0.f, 0.f, 0.f};
    bf16x8 At[4][2], B0[2][2], B1[2][2];
    const char* cA = abase(g, cur.pm); const char* cB = (const char*)g.Bt + (size_t)cur.pn * tstep;
    S.a_ready(cur);
    if constexpr (SP2) {
        PG8_STAGE(PG8_SB(0, 0), cB, voffB); PG8_STAGE(PG8_SB(0, 1), cB + hstep, voffB); PG8_STAGE(PG8_SA(0, 0), cA, voffA); PG8_STAGE(PG8_SA(0, 1), cA + hsA, voffA);
        if (wr == 1) PG8_BAR;
        PG8_WAIT_V(2); PG8_BAR;
        PG8_STAGE(PG8_SB(1, 0), cB + kstep, voffB); PG8_STAGE(PG8_SA(1, 0), cA + kstep, voffA); PG8_STAGE(PG8_SB(1, 1), cB + hstep + kstep, voffB);
        PG8_WAIT_V(6); PG8_BAR;
    } else {
        PG8_STAGE(PG8_SB(0, 0), cB, voffB); PG8_STAGE(PG8_SA(0, 0), cA, voffA); PG8_STAGE(PG8_SB(0, 1), cB + hstep, voffB); PG8_STAGE(PG8_SA(0, 1), cA + hsA, voffA);
        if (wr == 1) PG8_BAR;
        PG8_WAIT_V(4); PG8_BAR;
        PG8_STAGE(PG8_SB(1, 0), cB + kstep, voffB); PG8_STAGE(PG8_SA(1, 0), cA + kstep, voffA); PG8_STAGE(PG8_SB(1, 1), cB + hstep + kstep, voffB);
        PG8_WAIT_V(6); PG8_BAR;
    }
    for (;;) {
        const bool has_next = S.next(ui + 1, nxt);
        const char* nA = has_next ? abase(g, nxt.pm) : cA; const char* nB = has_next ? (const char*)g.Bt + (size_t)nxt.pn * tstep : cB;
        for (int t = 0; t < nt; t += 2) {
            const bool last = (t == nt - 2);
            const char* a1 = cA + (size_t)(t + 1) * kstep;
            const char* a2 = last ? nA : cA + (size_t)(t + 2) * kstep; const char* b2 = last ? nB : cB + (size_t)(t + 2) * kstep;
            const char* a3 = a2 + kstep; const char* b3 = b2 + kstep;
            if (last && has_next) S.a_ready(nxt);
            if constexpr (SP2) {
            PG8_LDB(B0, 0, 0); PG8_LDB(B1, 0, 1); PG8_SCHED; PG8_LDA(At, 0, 0); PG8_STAGE(PG8_SA(1, 1), a1 + hsA, voffA);
            PG8_WAIT_V(8); PG8_WAIT_L(0); PG8_BAR; PG8_MMA(0, 0, At, B0); PG8_MMA(0, 1, At, B1); PG8_BAR; PG8_SCHED;
            PG8_LDA(At, 0, 1); PG8_STAGE(PG8_SB(0, 0), b2, voffB); PG8_STAGE(PG8_SB(0, 1), b2 + hstep, voffB); PG8_STAGE(PG8_SA(0, 0), a2, voffA);
            PG8_WAIT_V(8); PG8_WAIT_L(0); PG8_BAR; PG8_MMA(1, 0, At, B0); PG8_MMA(1, 1, At, B1); PG8_BAR; PG8_SCHED;
            PG8_LDB(B0, 1, 0); PG8_LDB(B1, 1, 1); PG8_SCHED; PG8_LDA(At, 1, 0); PG8_STAGE(PG8_SA(0, 1), a2 + hsA, voffA);
            PG8_WAIT_V(8); PG8_WAIT_L(0); PG8_BAR; PG8_MMA(0, 0, At, B0); PG8_MMA(0, 1, At, B1); PG8_BAR; PG8_SCHED;
            PG8_LDA(At, 1, 1); PG8_STAGE(PG8_SB(1, 0), b3, voffB); PG8_STAGE(PG8_SB(1, 1), b3 + hstep, voffB); PG8_STAGE(PG8_SA(1, 0), a3, voffA);
            PG8_WAIT_V(8); PG8_WAIT_L(0); PG8_BAR; PG8_MMA(1, 0, At, B0); PG8_MMA(1, 1, At, B1); PG8_BAR; PG8_SCHED;
            } else {
            PG8_LDB(B0, 0, 0); PG8_SCHED; PG8_LDA(At, 0, 0); PG8_STAGE(PG8_SA(1, 1), a1 + hsA, voffA);
            PG8_WAIT_L(8); PG8_BAR; PG8_WAIT_L(0); PG8_MMA(0, 0, At, B0); PG8_BAR; PG8_SCHED;
            PG8_LDB(B1, 0, 1); PG8_STAGE(PG8_SB(0, 0), b2, voffB);
            PG8_BAR; PG8_WAIT_L(0); PG8_MMA(0, 1, At, B1); PG8_BAR;
            PG8_LDA(At, 0, 1); PG8_STAGE(PG8_SA(0, 0), a2, voffA);
            PG8_BAR; PG8_WAIT_L(0); PG8_MMA(1, 0, At, B0); PG8_BAR; PG8_SCHED;
            PG8_STAGE(PG8_SB(0, 1), b2 + hstep, voffB);
            PG8_WAIT_V(6); PG8_BAR; PG8_MMA(1, 1, At, B1); PG8_BAR;
            PG8_LDB(B0, 1, 0); PG8_SCHED; PG8_LDA(At, 1, 0); PG8_STAGE(PG8_SA(0, 1), a2 + hsA, voffA);
            PG8_WAIT_L(8); PG8_BAR; PG8_WAIT_L(0); PG8_MMA(0, 0, At, B0); PG8_BAR; PG8_SCHED;
            PG8_LDB(B1, 1, 1); PG8_STAGE(PG8_SB(1, 0), b3, voffB);
            PG8_BAR; PG8_WAIT_L(0); PG8_MMA(0, 1, At, B1); PG8_BAR;
            PG8_LDA(At, 1, 1); PG8_STAGE(PG8_SA(1, 0), a3, voffA);
            PG8_BAR; PG8_WAIT_L(0); PG8_MMA(1, 0, At, B0); PG8_BAR; PG8_SCHED;
            PG8_STAGE(PG8_SB(1, 1), b3 + hstep, voffB);
            PG8_WAIT_V(6); PG8_BAR; PG8_MMA(1, 1, At, B1); PG8_BAR;
            }
        }
        if constexpr (ALIGN_EPI) { if (wr == 0) PG8_BAR; }
        if constexpr (!Epi::AFTER_DRAIN) { E(acc, cur, wr, wc, fr, fq); S.done(cur); }
        if (!has_next) break;
#pragma unroll
        for (int a = 0; a < 2; ++a)
#pragma unroll
            for (int b = 0; b < 2; ++b)
#pragma unroll
                for (int m = 0; m < 4; ++m)
#pragma unroll
                    for (int n = 0; n < 2; ++n) acc[a][b][m][n] = (f32x4){0.f, 0.f, 0.f, 0.f};
        cur = nxt; cA = nA; cB = nB; ++ui;
        if constexpr (ALIGN_EPI) { if (wr == 1) PG8_BAR; }
    }
    PG8_WAIT_V(0);
    if constexpr (!ALIGN_EPI) { if (wr == 0) PG8_BAR; }
    PG8_BAR;
    if constexpr (Epi::AFTER_DRAIN) { E.fused(acc, cur, wr, wc, fr, fq, lds, wid, lane); S.done(cur); }
#undef PG8_SA
#undef PG8_SB
#undef PG8_STAGE
#undef PG8_LDA
#undef PG8_LDB
#undef PG8_MMA
#undef PG8_WAIT_V
#undef PG8_WAIT_L
#undef PG8_BAR
#undef PG8_SCHED
}
}

struct Frame {
    LAS unsigned char* lds;
    int tid, lane, wave, G;
    const float* in[24];
    float* out;
    bf16_t *Wqkv, *Wo, *Wup, *Wdn, *Wgin, *Wgo;
    bf16_t *XN, *OB;
    bf16_t *R1;
    float *LA, *SSQ, *ropec, *ropes;
};
__device__ __forceinline__ float wave_sum(float v) {
#pragma unroll
    for (int o = 1; o < 64; o <<= 1) v += __shfl_xor(v, o);
    return v;
}
__device__ __forceinline__ float wave_max(float v) {
#pragma unroll
    for (int o = 1; o < 64; o <<= 1) v = fmaxf(v, __shfl_xor(v, o));
    return v;
}
#define LDS_WAIT() asm volatile("s_waitcnt lgkmcnt(0)" ::: "memory")

__device__ __forceinline__ void p0_transpose_item(const float* W, int K, int N, bf16_t* WT, int up, LAS float* scr, int item, int lane) {
    const int nblk = N / 32, kb = item / nblk, nb = item % nblk, k0 = 64 * kb, n0 = 32 * nb;
#pragma unroll 8
    for (int i = 0; i < 32; ++i) { const int kk = 2 * i + (lane >> 5); scr[kk * 33 + (lane & 31)] = W[(size_t)(k0 + kk) * N + n0 + (lane & 31)]; }
    LDS_WAIT(); asm volatile("" ::: "memory");
    int r0 = n0;
    if (up) { const int hi = n0 >= FF, c = n0 - hi * FF; r0 = 256 * (c >> 7) + 128 * hi + (c & 127); }
    const int c = lane & 7;
#pragma unroll
    for (int j = 0; j < 4; ++j) { const int n = (lane >> 3) + 8 * j; const LAS float* s = scr + (8 * c) * 33 + n;
        u32x4 o; o.x = cvt_pk_bf16(s[0 * 33], s[1 * 33]); o.y = cvt_pk_bf16(s[2 * 33], s[3 * 33]); o.z = cvt_pk_bf16(s[4 * 33], s[5 * 33]); o.w = cvt_pk_bf16(s[6 * 33], s[7 * 33]);
        *(u32x4*)(WT + (size_t)(r0 + n) * K + k0 + 8 * c) = o; }
    LDS_WAIT(); asm volatile("" ::: "memory");
}
__device__ __forceinline__ void p0_prologue(const Frame& F) {
    LAS float* scr = (LAS float*)(F.lds + F.wave * 16384);
    const int gw = blockIdx.x * 8 + F.wave, NGW = F.G * 8;
    constexpr int I_QKV = 16 * 40, I_O = 16 * 32, I_GIN = 16 * 96, I_UP = 16 * 176, I_DN = 44 * 32;
    constexpr int NITEMS = I_QKV + 2 * I_O + I_GIN + 2 * I_UP + 2 * I_DN;
    for (int it = gw; it < NITEMS; it += NGW) {
        int r = it;
        if (r < I_QKV) { p0_transpose_item(F.in[6], DM, NQKV, F.Wqkv, 0, scr, r, F.lane); continue; } r -= I_QKV;
        if (r < I_O) { p0_transpose_item(F.in[9], DM, DM, F.Wo, 0, scr, r, F.lane); continue; } r -= I_O;
        if (r < I_O) { p0_transpose_item(F.in[15], DM, DM, F.Wgo, 0, scr, r, F.lane); continue; } r -= I_O;
        if (r < I_GIN) { p0_transpose_item(F.in[10], DM, NPROJ, F.Wgin, 0, scr, r, F.lane); continue; } r -= I_GIN;
        if (r < 2 * I_UP) { const int l = r / I_UP; p0_transpose_item(F.in[16] + (size_t)l * DM * NUP, DM, NUP, F.Wup + (size_t)l * NUP * DM, 1, scr, r % I_UP, F.lane); continue; } r -= 2 * I_UP;
        { const int l = r / I_DN; p0_transpose_item(F.in[19] + (size_t)l * FF * DM, FF, DM, F.Wdn + (size_t)l * DM * FF, 0, scr, r % I_DN, F.lane); }
    }
    const int gt = blockIdx.x * 512 + F.tid, NGT = F.G * 512;
    for (int idx = gt; idx < 512 * 128; idx += NGT) { const int n = idx >> 7, k0 = (idx & 127) * 8; float s[8];
#pragma unroll
        for (int e = 0; e < 8; ++e) s[e] = 0.f;
        for (int r = 0; r < 16; ++r) { const float w2 = F.in[12][r * 512 + n];
#pragma unroll
            for (int e = 0; e < 8; ++e) s[e] += F.in[11][(k0 + e) * 16 + r] * w2; }
        u32x4 o; o.x = cvt_pk_bf16(s[0], s[1]); o.y = cvt_pk_bf16(s[2], s[3]); o.z = cvt_pk_bf16(s[4], s[5]); o.w = cvt_pk_bf16(s[6], s[7]);
        *(u32x4*)(F.Wgin + (size_t)(NPROJ + n) * DM + k0) = o; }
    for (int idx = gt; idx < (MP + NS) * 128; idx += NGT) { const int i = idx >> 7, c = (idx & 127) * 8;
        const float* xp = (i < MP ? F.in[0] + (size_t)i * DM : F.in[1] + (size_t)(i - MP) * DM) + c; const int r = i < MP ? i : SROW + (i - MP);
        const f32x4 a = *(const f32x4*)xp, b = *(const f32x4*)(xp + 4);
        u32x4 o; o.x = cvt_pk_bf16(a[0], a[1]); o.y = cvt_pk_bf16(a[2], a[3]); o.z = cvt_pk_bf16(b[0], b[1]); o.w = cvt_pk_bf16(b[2], b[3]);
        *(u32x4*)(F.XN + (size_t)r * DM + c) = o; }
    for (int idx = gt; idx < 2049 * 32; idx += NGT) { const int p = idx >> 5, i = idx & 31;
        const float inv = (float)(1.0 / pow(10000.0, (double)i / 32.0)); const float pos = p < 2048 ? (float)p : 16384.f; const float ang = pos * inv;
        F.ropec[idx] = (float)cos((double)ang); F.ropes[idx] = (float)sin((double)ang); }
}

__device__ __forceinline__ void ln_phase(const Frame& F, const float* g, const float* b, bool write_xn) {
    const int gw = blockIdx.x * 8 + F.wave, NGW = F.G * 8, lane = F.lane;
    f32x4 gv[4], bv[4];
#pragma unroll
    for (int j = 0; j < 4; ++j) { gv[j] = *(const f32x4*)(g + 4 * lane + 256 * j); bv[j] = *(const f32x4*)(b + 4 * lane + 256 * j); }
    for (int i = gw; i < MP + NS; i += NGW) {
        float* row = F.out + (size_t)i * DM + 4 * lane;
        f32x4 v[4]; float s = 0.f;
#pragma unroll
        for (int j = 0; j < 4; ++j) { v[j] = *(const f32x4*)(row + 256 * j); s += (v[j][0] + v[j][1]) + (v[j][2] + v[j][3]); }
        const float mean = wave_sum(s) * (1.f / DM); float s2 = 0.f;
#pragma unroll
        for (int j = 0; j < 4; ++j) { v[j] = v[j] - mean; s2 += (v[j][0] * v[j][0] + v[j][1] * v[j][1]) + (v[j][2] * v[j][2] + v[j][3] * v[j][3]); }
        const float rstd = 1.f / sqrtf(wave_sum(s2) * (1.f / DM) + LN_EPS);
        const int r = i < MP ? i : SROW + (i - MP);
        bf16_t* xr = F.XN + (size_t)r * DM + 4 * lane;
#pragma unroll
        for (int j = 0; j < 4; ++j) { const f32x4 o = v[j] * rstd * gv[j] + bv[j]; *(f32x4*)(row + 256 * j) = o;
            if (write_xn) { u32x2 w; w.x = cvt_pk_bf16(o[0], o[1]); w.y = cvt_pk_bf16(o[2], o[3]); *(u32x2*)(xr + 256 * j) = w; } }
    }
}

__device__ __forceinline__ void attn_prompt_unit(const Frame& F, int b, int kvh, int qb) {
    LAS bf16_t* Ks = (LAS bf16_t*)F.lds;
    LAS bf16_t* Vt = (LAS bf16_t*)(F.lds + 36864);
    const int tid = F.tid, lane = F.lane, w = F.wave, fr = lane & 15, g = lane >> 4;
    const bf16_t* QKV = F.R1; const bool last = (qb == 15);
#pragma unroll
    for (int rep = 0; rep < 2; ++rep) {
        const int idx = tid + 512 * rep, s = idx >> 2, d0 = 8 * (idx & 3), tk = qb * 128 - 128 + s;
        u32x4 o0 = {0u, 0u, 0u, 0u}, o1 = {0u, 0u, 0u, 0u};
        if (tk >= 0) {
            const bf16_t* kp = QKV + (size_t)(b * SEQ + tk) * NQKV + 1024 + kvh * 64 + d0;
            const u32x4 k0 = *(const u32x4*)kp, k1 = *(const u32x4*)(kp + 32);
            const float* cp = F.ropec + tk * 32 + d0; const float* sp = F.ropes + tk * 32 + d0;
            const f32x4 c0 = *(const f32x4*)cp, c1 = *(const f32x4*)(cp + 4), s0 = *(const f32x4*)sp, s1 = *(const f32x4*)(sp + 4);
            float r0[8], r1[8];
#pragma unroll
            for (int e = 0; e < 4; ++e) {
                const float xa = bflo(k0[e]), xb = bfhi(k0[e]), ya = bflo(k1[e]), yb = bfhi(k1[e]);
                const float ca = e < 2 ? c0[2 * e] : c1[2 * e - 4], cb = e < 2 ? c0[2 * e + 1] : c1[2 * e - 3];
                const float sa = e < 2 ? s0[2 * e] : s1[2 * e - 4], sb = e < 2 ? s0[2 * e + 1] : s1[2 * e - 3];
                r0[2 * e] = xa * ca - ya * sa; r0[2 * e + 1] = xb * cb - yb * sb; r1[2 * e] = ya * ca + xa * sa; r1[2 * e + 1] = yb * cb + xb * sb;
            }
            o0 = (u32x4){cvt_pk_bf16(r0[0], r0[1]), cvt_pk_bf16(r0[2], r0[3]), cvt_pk_bf16(r0[4], r0[5]), cvt_pk_bf16(r0[6], r0[7])};
            o1 = (u32x4){cvt_pk_bf16(r1[0], r1[1]), cvt_pk_bf16(r1[2], r1[3]), cvt_pk_bf16(r1[4], r1[5]), cvt_pk_bf16(r1[6], r1[7])};
            if (last && s >= 128) { float* ko = F.out + O_KP + ((size_t)(b * 128 + s - 128) * 2 + kvh) * 64 + d0;
                *(f32x4*)ko = (f32x4){r0[0], r0[1], r0[2], r0[3]}; *(f32x4*)(ko + 4) = (f32x4){r0[4], r0[5], r0[6], r0[7]};
                *(f32x4*)(ko + 32) = (f32x4){r1[0], r1[1], r1[2], r1[3]}; *(f32x4*)(ko + 36) = (f32x4){r1[4], r1[5], r1[6], r1[7]}; }
        }
        *(LAS u32x4*)(Ks + s * 72 + d0) = o0; *(LAS u32x4*)(Ks + s * 72 + 32 + d0) = o1;
    }
#pragma unroll
    for (int rep = 0; rep < 4; ++rep) {
        const int idx = tid + 512 * rep, s = idx >> 3, d0 = 8 * (idx & 7), tk = qb * 128 - 128 + s;
        u32x4 v = {0u, 0u, 0u, 0u};
        if (tk >= 0) { v = *(const u32x4*)(QKV + (size_t)(b * SEQ + tk) * NQKV + 1152 + kvh * 64 + d0);
            if (last && s >= 128) { float* vo = F.out + O_VP + ((size_t)(b * 128 + s - 128) * 2 + kvh) * 64 + d0;
                *(f32x4*)vo = (f32x4){bflo(v[0]), bfhi(v[0]), bflo(v[1]), bfhi(v[1])}; *(f32x4*)(vo + 4) = (f32x4){bflo(v[2]), bfhi(v[2]), bflo(v[3]), bfhi(v[3])}; } }
#pragma unroll
        for (int e = 0; e < 4; ++e) { Vt[(d0 + 2 * e) * 272 + s] = (bf16_t)(v[e] & 0xffffu); Vt[(d0 + 2 * e + 1) * 272 + s] = (bf16_t)(v[e] >> 16); }
    }
    __syncthreads();
    const int h = kvh * 8 + w; const float sink = F.in[8][h];
    for (int qg = 0; qg < 8; ++qg) {
        const int i = 16 * qg + fr, pos = qb * 128 + i; const size_t rq = (size_t)(b * SEQ + pos);
        bf16x8 Bq0, Bq1;
        { const bf16_t* qp = QKV + rq * NQKV + h * 64 + 8 * g; const u32x4 q0 = *(const u32x4*)qp, q1 = *(const u32x4*)(qp + 32);
            const float* cp = F.ropec + pos * 32 + 8 * g; const float* sp = F.ropes + pos * 32 + 8 * g;
            const f32x4 c0 = *(const f32x4*)cp, c1 = *(const f32x4*)(cp + 4), s0 = *(const f32x4*)sp, s1 = *(const f32x4*)(sp + 4);
            float r0[8], r1[8];
#pragma unroll
            for (int e = 0; e < 4; ++e) {
                const float xa = bflo(q0[e]), xb = bfhi(q0[e]), ya = bflo(q1[e]), yb = bfhi(q1[e]);
                const float ca = e < 2 ? c0[2 * e] : c1[2 * e - 4], cb = e < 2 ? c0[2 * e + 1] : c1[2 * e - 3];
                const float sa = e < 2 ? s0[2 * e] : s1[2 * e - 4], sb = e < 2 ? s0[2 * e + 1] : s1[2 * e - 3];
                r0[2 * e] = (xa * ca - ya * sa) * 0.125f; r0[2 * e + 1] = (xb * cb - yb * sb) * 0.125f; r1[2 * e] = (ya * ca + xa * sa) * 0.125f; r1[2 * e + 1] = (yb * cb + xb * sb) * 0.125f;
            }
            Bq0 = mk8(cvt_pk_bf16(r0[0], r0[1]), cvt_pk_bf16(r0[2], r0[3]), cvt_pk_bf16(r0[4], r0[5]), cvt_pk_bf16(r0[6], r0[7]));
            Bq1 = mk8(cvt_pk_bf16(r1[0], r1[1]), cvt_pk_bf16(r1[2], r1[3]), cvt_pk_bf16(r1[4], r1[5]), cvt_pk_bf16(r1[6], r1[7])); }
        f32x4 sc[9]; float mx = -1e30f;
#pragma unroll
        for (int tt = 0; tt < 9; ++tt) {
            const LAS bf16_t* kr = Ks + ((qg + tt) * 16 + fr) * 72 + 8 * g;
            f32x4 a = {0.f, 0.f, 0.f, 0.f};
            a = mfma16(*(const LAS bf16x8*)kr, Bq0, a); a = mfma16(*(const LAS bf16x8*)(kr + 32), Bq1, a);
#pragma unroll
            for (int e = 0; e < 4; ++e) { const int dlt = 16 * tt + 4 * g + e - fr; const bool ok = dlt >= 1 && dlt <= 128 && (qb > 0 || 16 * (qg + tt) + 4 * g + e >= 128);
                a[e] = ok ? a[e] : -1e30f; mx = fmaxf(mx, a[e]); }
            sc[tt] = a;
        }
        mx = fmaxf(mx, __shfl_xor(mx, 16)); mx = fmaxf(mx, __shfl_xor(mx, 32)); mx = fmaxf(mx, sink);
        float sum = 0.f;
#pragma unroll
        for (int tt = 0; tt < 9; ++tt)
#pragma unroll
            for (int e = 0; e < 4; ++e) { const float p = __expf(sc[tt][e] - mx); sc[tt][e] = p; sum += p; }
        sum += __shfl_xor(sum, 16); sum += __shfl_xor(sum, 32);
        const float inv = 1.f / (sum + __expf(sink - mx));
        bf16x8 P[5];
#pragma unroll
        for (int ks = 0; ks < 5; ++ks) {
            const f32x4 lo = sc[2 * ks] * inv; f32x4 hi = {0.f, 0.f, 0.f, 0.f}; if (2 * ks + 1 < 9) hi = sc[(2 * ks + 1) < 9 ? 2 * ks + 1 : 8] * inv;
            P[ks] = mk8(cvt_pk_bf16(lo[0], lo[1]), cvt_pk_bf16(lo[2], lo[3]), cvt_pk_bf16(hi[0], hi[1]), cvt_pk_bf16(hi[2], hi[3]));
        }
        bf16_t* orow = F.XN + rq * DM + h * 64 + 4 * g;
#pragma unroll
        for (int nt = 0; nt < 4; ++nt) {
            const LAS bf16_t* vr = Vt + (16 * nt + fr) * 272 + 4 * g;
            f32x4 o = {0.f, 0.f, 0.f, 0.f};
#pragma unroll
            for (int ks = 0; ks < 5; ++ks) { const int k0 = qg + 2 * ks, k1 = (k0 + 1) < 16 ? (k0 + 1) : 15;
                const u32x2 lo = *(const LAS u32x2*)(vr + k0 * 16), hi = *(const LAS u32x2*)(vr + k1 * 16);
                o = mfma16(mk8(lo.x, lo.y, hi.x, hi.y), P[ks], o); }
            u32x2 wv; wv.x = cvt_pk_bf16(o[0], o[1]); wv.y = cvt_pk_bf16(o[2], o[3]);
            *(u32x2*)(orow + 16 * nt) = wv;
#ifdef DBG_O
            *(f32x4*)(F.out + rq * DM + h * 64 + 16 * nt + 4 * g) = o;
#endif
        }
    }
    __syncthreads();
}
__device__ __forceinline__ void attn_sample_unit(const Frame& F, int b) {
    LAS bf16_t* Kc = (LAS bf16_t*)F.lds;
    LAS bf16_t* Vc = (LAS bf16_t*)(F.lds + 34816);
    LAS float* qs = (LAS float*)(F.lds + 69632);
    LAS float* ps = (LAS float*)(F.lds + 73728);
    const int tid = F.tid, lane = F.lane, w = F.wave;
    const float* ck = F.in[2] + (size_t)b * 128 * 128; const float* cv = F.in[3] + (size_t)b * 128 * 128;
    float* nk = F.out + O_KS + (size_t)b * 128 * 128; float* nv = F.out + O_VS + (size_t)b * 128 * 128;
    for (int idx = tid; idx < 127 * 32; idx += 512) { const int s = 1 + (idx >> 5), c4 = 4 * (idx & 31);
        const f32x4 kv = *(const f32x4*)(ck + s * 128 + c4), vv = *(const f32x4*)(cv + s * 128 + c4);
        *(f32x4*)(nk + (s - 1) * 128 + c4) = kv; *(f32x4*)(nv + (s - 1) * 128 + c4) = vv;
        *(LAS u32x2*)(Kc + (s - 1) * 136 + c4) = (u32x2){cvt_pk_bf16(kv[0], kv[1]), cvt_pk_bf16(kv[2], kv[3])};
        *(LAS u32x2*)(Vc + (s - 1) * 136 + c4) = (u32x2){cvt_pk_bf16(vv[0], vv[1]), cvt_pk_bf16(vv[2], vv[3])}; }
    const int row = SROW + b; const bf16_t* qrow = F.R1 + (size_t)row * NQKV;
    { const int h = tid >> 5, dd = tid & 31; const float q0 = bf2f(qrow[h * 64 + dd]), q1 = bf2f(qrow[h * 64 + dd + 32]);
        const float c = F.ropec[2048 * 32 + dd], s = F.ropes[2048 * 32 + dd];
        qs[h * 64 + dd] = (q0 * c - q1 * s) * 0.125f; qs[h * 64 + dd + 32] = (q1 * c + q0 * s) * 0.125f; }
    if (tid < 64) { const int kvh = tid >> 5, dd = tid & 31; const float k0 = bf2f(qrow[1024 + kvh * 64 + dd]), k1 = bf2f(qrow[1024 + kvh * 64 + dd + 32]);
        const float c = F.ropec[2048 * 32 + dd], s = F.ropes[2048 * 32 + dd]; const float r0 = k0 * c - k1 * s, r1 = k1 * c + k0 * s;
        nk[127 * 128 + kvh * 64 + dd] = r0; nk[127 * 128 + kvh * 64 + dd + 32] = r1; Kc[127 * 136 + kvh * 64 + dd] = f2bf(r0); Kc[127 * 136 + kvh * 64 + dd + 32] = f2bf(r1); }
    else if (tid < 192) { const int j = tid - 64; const bf16_t vb = qrow[1152 + j]; nv[127 * 128 + j] = bf2f(vb); Vc[127 * 136 + j] = vb; }
    __syncthreads();
#pragma unroll
    for (int r = 0; r < 4; ++r) { const int idx = tid + 512 * r, h = idx >> 7, s = idx & 127, kvh = h >> 3; float dot = 0.f;
#pragma unroll
        for (int c = 0; c < 8; ++c) { const u32x4 kk = *(const LAS u32x4*)(Kc + s * 136 + kvh * 64 + 8 * c); const f32x4 qa = *(const LAS f32x4*)(qs + h * 64 + 8 * c), qb = *(const LAS f32x4*)(qs + h * 64 + 8 * c + 4);
            dot += bflo(kk[0]) * qa[0] + bfhi(kk[0]) * qa[1] + bflo(kk[1]) * qa[2] + bfhi(kk[1]) * qa[3] + bflo(kk[2]) * qb[0] + bfhi(kk[2]) * qb[1] + bflo(kk[3]) * qb[2] + bfhi(kk[3]) * qb[3]; }
        ps[h * 128 + s] = dot; }
    __syncthreads();
#pragma unroll
    for (int x = 0; x < 2; ++x) { const int hh = w + 8 * x; const float sink = F.in[8][hh];
        const float v0 = ps[hh * 128 + lane], v1 = ps[hh * 128 + 64 + lane];
        const float m = fmaxf(wave_max(fmaxf(v0, v1)), sink); const float e0 = __expf(v0 - m), e1 = __expf(v1 - m);
        const float inv = 1.f / (wave_sum(e0 + e1) + __expf(sink - m));
        ps[hh * 128 + lane] = e0 * inv; ps[hh * 128 + 64 + lane] = e1 * inv; }
    __syncthreads();
#pragma unroll
    for (int r = 0; r < 2; ++r) { const int idx = tid + 512 * r, h = idx >> 6, d = idx & 63, kvh = h >> 3; float acc = 0.f;
        for (int s = 0; s < 128; ++s) acc += ps[h * 128 + s] * bf2f(Vc[s * 136 + kvh * 64 + d]);
        F.XN[(size_t)row * DM + h * 64 + d] = f2bf(acc);
#ifdef DBG_O
        F.out[O_YS + (size_t)b * DM + h * 64 + d] = acc;
#endif
        }
    __syncthreads();
}

__device__ __forceinline__ void gla_prompt_unit(const Frame& F, int b, int h, int vs) {
    LAS bf16_t* Qin = (LAS bf16_t*)F.lds;
    LAS bf16_t* Kin = (LAS bf16_t*)(F.lds + 17408);
    LAS bf16_t* KoT = (LAS bf16_t*)(F.lds + 34816);
    LAS bf16_t* Vt = (LAS bf16_t*)(F.lds + 53248);
    LAS float* seg = (LAS float*)(F.lds + 62464);
    LAS float* dec = (LAS float*)(F.lds + 66560);
    LAS float* ssl = (LAS float*)(F.lds + 67072);
    const int tid = F.tid, lane = F.lane, w = F.wave, fr = lane & 15, g = lane >> 4, vt = w & 3, th = w >> 2;
    const bf16_t* P = F.R1; const float* LA = F.LA;
    f32x4 S[8];
#pragma unroll
    for (int i = 0; i < 8; ++i) S[i] = (f32x4){0.f, 0.f, 0.f, 0.f};
    f32x2 rla[8]; unsigned rq[8], rk[8]; u32x4 rv;
#define GLA_LOAD(c) do { const int row0_ = b * SEQ + 64 * (c); _Pragma("unroll") for (int i = 0; i < 8; ++i) { const size_t ro = (size_t)(row0_ + 8 * w + i); \
        rla[i] = *(const f32x2*)(LA + ro * 512 + h * 128 + 2 * lane); rq[i] = *(const unsigned*)(P + ro * NPROJ + h * 128 + 2 * lane); rk[i] = *(const unsigned*)(P + ro * NPROJ + 512 + h * 128 + 2 * lane); } \
        rv = *(const u32x4*)(P + (size_t)(row0_ + (tid >> 3)) * NPROJ + 1024 + h * 256 + vs * 64 + (tid & 7) * 8); } while (0)
    GLA_LOAD(0);
    for (int c = 0; c < 32; ++c) {
        const int row0 = b * SEQ + 64 * c;
        float c0[8], c1[8]; float run0 = 0.f, run1 = 0.f;
#pragma unroll
        for (int i = 0; i < 8; ++i) { run0 += rla[i].x; run1 += rla[i].y; c0[i] = run0; c1[i] = run1; }
        *(LAS f32x2*)(seg + w * 128 + 2 * lane) = (f32x2){run0, run1};
        __syncthreads();
        float pre0 = 0.f, pre1 = 0.f, tot0 = 0.f, tot1 = 0.f;
#pragma unroll
        for (int x = 0; x < 8; ++x) { const f32x2 sv = *(const LAS f32x2*)(seg + x * 128 + 2 * lane); tot0 += sv.x; tot1 += sv.y; if (x < w) { pre0 += sv.x; pre1 += sv.y; } }
#pragma unroll
        for (int i = 0; i < 8; ++i) { const int t = 8 * w + i; const float b0 = pre0 + c0[i], b1 = pre1 + c1[i];
            const float q0 = bflo(rq[i]), q1 = bfhi(rq[i]), k0 = bflo(rk[i]), k1 = bfhi(rk[i]);
            *(LAS unsigned*)(Qin + t * 136 + 2 * lane) = cvt_pk_bf16(q0 * QS_GLA * __expf(b0), q1 * QS_GLA * __expf(b1));
            *(LAS unsigned*)(Kin + t * 136 + 2 * lane) = cvt_pk_bf16(k0 * __expf(-b0), k1 * __expf(-b1));
            KoT[(2 * lane) * 72 + t] = f2bf(k0 * __expf(tot0 - b0)); KoT[(2 * lane + 1) * 72 + t] = f2bf(k1 * __expf(tot1 - b1)); }
        if (w == 0) *(LAS f32x2*)(dec + 2 * lane) = (f32x2){__expf(tot0), __expf(tot1)};
        { const int t = tid >> 3, j0 = (tid & 7) * 8;
#pragma unroll
            for (int e = 0; e < 4; ++e) { Vt[(j0 + 2 * e) * 72 + t] = (bf16_t)(rv[e] & 0xffffu); Vt[(j0 + 2 * e + 1) * 72 + t] = (bf16_t)(rv[e] >> 16); } }
        __syncthreads();
        if (c < 31) GLA_LOAD(c + 1);
#pragma unroll
        for (int ti = 0; ti < 2; ++ti) {
            const int tt = th == 0 ? (ti == 0 ? 0 : 3) : (ti == 0 ? 1 : 2);
            f32x4 o = {0.f, 0.f, 0.f, 0.f};
            const LAS bf16_t* qrow = Qin + (tt * 16 + fr) * 136;
#pragma unroll
            for (int ks = 0; ks < 4; ++ks) {
                const bf16x8 A = mk8(cvt_pk_bf16(S[2 * ks][0], S[2 * ks][1]), cvt_pk_bf16(S[2 * ks][2], S[2 * ks][3]), cvt_pk_bf16(S[2 * ks + 1][0], S[2 * ks + 1][1]), cvt_pk_bf16(S[2 * ks + 1][2], S[2 * ks + 1][3]));
                const u32x2 blo = *(const LAS u32x2*)(qrow + (2 * ks) * 16 + 4 * g), bhi = *(const LAS u32x2*)(qrow + (2 * ks + 1) * 16 + 4 * g);
                o = mfma16(A, mk8(blo.x, blo.y, bhi.x, bhi.y), o);
            }
#pragma unroll
            for (int sp = 0; sp < 2; ++sp) {
                if (2 * sp <= tt) {
                    f32x4 at[2];
#pragma unroll
                    for (int x = 0; x < 2; ++x) { const int st = 2 * sp + x; at[x] = (f32x4){0.f, 0.f, 0.f, 0.f};
                        if (st <= tt) { const LAS bf16_t* kr = Kin + (st * 16 + fr) * 136 + 8 * g;
#pragma unroll
                            for (int ks = 0; ks < 4; ++ks) at[x] = mfma16(*(const LAS bf16x8*)(kr + 32 * ks), *(const LAS bf16x8*)(qrow + 8 * g + 32 * ks), at[x]);
                            if (st == tt) {
#pragma unroll
                                for (int e = 0; e < 4; ++e) if (4 * g + e > fr) at[x][e] = 0.f; } } }
                    const LAS bf16_t* vr = Vt + (vt * 16 + fr) * 72 + 4 * g;
                    const u32x2 alo = *(const LAS u32x2*)(vr + (2 * sp) * 16), ahi = *(const LAS u32x2*)(vr + (2 * sp + 1) * 16);
                    o = mfma16(mk8(alo.x, alo.y, ahi.x, ahi.y), mk8(cvt_pk_bf16(at[0][0], at[0][1]), cvt_pk_bf16(at[0][2], at[0][3]), cvt_pk_bf16(at[1][0], at[1][1]), cvt_pk_bf16(at[1][2], at[1][3])), o);
                }
            }
            const int t = tt * 16 + fr;
            u32x2 wv; wv.x = cvt_pk_bf16(o[0], o[1]); wv.y = cvt_pk_bf16(o[2], o[3]);
            *(u32x2*)(F.XN + (size_t)(row0 + t) * DM + h * 256 + vs * 64 + vt * 16 + 4 * g) = wv;
            float ss = (o[0] * o[0] + o[1] * o[1]) + (o[2] * o[2] + o[3] * o[3]);
            ss += __shfl_xor(ss, 16); ss += __shfl_xor(ss, 32);
            if (g == 0) ssl[vt * 64 + t] = ss;
        }
#pragma unroll
        for (int dt = 0; dt < 8; ++dt) {
            const f32x4 dv = *(const LAS f32x4*)(dec + dt * 16 + 4 * g);
            f32x4 acc = S[dt] * dv;
            const LAS bf16_t* ar = KoT + (dt * 16 + fr) * 72 + 8 * g; const LAS bf16_t* br = Vt + (vt * 16 + fr) * 72 + 8 * g;
            acc = mfma16(*(const LAS bf16x8*)ar, *(const LAS bf16x8*)br, acc); acc = mfma16(*(const LAS bf16x8*)(ar + 32), *(const LAS bf16x8*)(br + 32), acc);
            S[dt] = acc;
        }
        __syncthreads();
        if (w == 0) F.SSQ[(size_t)(row0 + lane) * 16 + h * 4 + vs] = (ssl[lane] + ssl[64 + lane]) + (ssl[128 + lane] + ssl[192 + lane]);
    }
#undef GLA_LOAD
    if (th == 0) {
        float* so = F.out + O_GP + ((size_t)(b * 4 + h) * 128) * 256 + vs * 64 + vt * 16 + fr;
#pragma unroll
        for (int dt = 0; dt < 8; ++dt)
#pragma unroll
            for (int e = 0; e < 4; ++e) so[(size_t)(dt * 16 + 4 * g + e) * 256] = S[dt][e];
    }
    __syncthreads();
}
__device__ __forceinline__ void gla_sample_unit(const Frame& F, int b, int h) {
    LAS float* red = (LAS float*)F.lds;
    LAS float* ssr = red + 2048;
    const int tid = F.tid, lane = F.lane, w = F.wave;
    const int row = SROW + b; const bf16_t* pr = F.R1 + (size_t)row * NPROJ; const float* la = F.LA + (size_t)row * 512 + h * 128;
    const u32x2 vv = *(const u32x2*)(pr + 1024 + h * 256 + 4 * lane); const f32x4 v4 = {bflo(vv.x), bfhi(vv.x), bflo(vv.y), bfhi(vv.y)};
    const float* s0 = F.in[4] + ((size_t)(b * 4 + h) * 128) * 256 + 4 * lane; float* s1 = F.out + O_GS + ((size_t)(b * 4 + h) * 128) * 256 + 4 * lane;
    f32x4 o4 = {0.f, 0.f, 0.f, 0.f};
#pragma unroll 4
    for (int i = 0; i < 16; ++i) { const int d = 16 * w + i; const float a = __expf(la[d]), kd = bf2f(pr[512 + h * 128 + d]), qd = bf2f(pr[h * 128 + d]) * QS_GLA;
        f32x4 s = *(const f32x4*)(s0 + (size_t)d * 256); s = s * a + v4 * kd; *(f32x4*)(s1 + (size_t)d * 256) = s; o4 += s * qd; }
    *(LAS f32x4*)(red + w * 256 + 4 * lane) = o4;
    __syncthreads();
    float o = 0.f, ss = 0.f;
    if (tid < 256) {
#pragma unroll
        for (int x = 0; x < 8; ++x) o += red[x * 256 + tid];
        F.XN[(size_t)row * DM + h * 256 + tid] = f2bf(o); ss = o * o; }
    ss = wave_sum(ss); if (lane == 0) ssr[w] = ss;
    __syncthreads();
    if (tid == 0) *(f32x4*)(F.SSQ + (size_t)row * 16 + h * 4) = (f32x4){(ssr[0] + ssr[1]) + (ssr[2] + ssr[3]), 0.f, 0.f, 0.f};
    __syncthreads();
}
__device__ __forceinline__ void gla_norm_phase(const Frame& F) {
    const int gw = blockIdx.x * 8 + F.wave, NGW = F.G * 8, lane = F.lane, hh = lane >> 4;
    f32x4 ng[4];
#pragma unroll
    for (int j = 0; j < 4; ++j) ng[j] = *(const f32x4*)(F.in[14] + (lane & 15) * 16 + 4 * j);
    for (int i = gw; i < MP + NS; i += NGW) {
        const int r = i < MP ? i : SROW + (i - MP);
        const f32x4 sq = *(const f32x4*)(F.SSQ + (size_t)r * 16 + hh * 4);
        const float rs = 1.f / sqrtf(((sq[0] + sq[1]) + (sq[2] + sq[3])) * (1.f / 256.f) + 1e-6f);
        bf16_t* op = F.XN + (size_t)r * DM + lane * 16; const bf16_t* gp = F.R1 + (size_t)r * NPROJ + 2048 + lane * 16;
#pragma unroll
        for (int x = 0; x < 2; ++x) { const u32x4 ov = *(const u32x4*)(op + 8 * x), gv = *(const u32x4*)(gp + 8 * x); u32x4 w;
#pragma unroll
            for (int e = 0; e < 4; ++e) { const float o0 = bflo(ov[e]), o1 = bfhi(ov[e]), g0 = bflo(gv[e]), g1 = bfhi(gv[e]);
                const int k = 8 * x + 2 * e; const float n0 = ng[k >> 2][k & 3], n1 = ng[(k + 1) >> 2][(k + 1) & 3];
                w[e] = cvt_pk_bf16(o0 * rs * n0 * (g0 / (1.f + __expf(-g0))), o1 * rs * n1 * (g1 / (1.f + __expf(-g1)))); }
            *(u32x4*)(op + 8 * x) = w; }
    }
}

struct Args { const float* in[24]; float* out; unsigned char* ws; int ph_lo, ph_hi; };
constexpr int NPHASE = 16;
__global__ void __launch_bounds__(512, 2) mega_fwd(Args args) {
    extern __shared__ __attribute__((aligned(16))) unsigned char lds[];
    cg::grid_group grid = cg::this_grid();
    Frame F;
    F.lds = (LAS unsigned char*)lds;
    F.tid = threadIdx.x; F.lane = F.tid & 63; F.wave = __builtin_amdgcn_readfirstlane(F.tid >> 6); F.G = gridDim.x;
#pragma unroll
    for (int i = 0; i < 24; ++i) F.in[i] = args.in[i];
    F.out = args.out;
    unsigned char* ws = args.ws;
    F.Wqkv = (bf16_t*)(ws + WS_WQKV); F.Wo = (bf16_t*)(ws + WS_WO); F.Wup = (bf16_t*)(ws + WS_WUP); F.Wdn = (bf16_t*)(ws + WS_WDN); F.Wgin = (bf16_t*)(ws + WS_WGIN); F.Wgo = (bf16_t*)(ws + WS_WGO);
    F.XN = (bf16_t*)(ws + WS_XN) + 8 * DM; F.OB = (bf16_t*)(ws + 400 * MiB); F.R1 = (bf16_t*)(ws + WS_R1); F.LA = (float*)(ws + WS_LA); F.SSQ = (float*)(ws + WS_SSQ);
    F.ropec = (float*)(ws + WS_ROPE); F.ropes = F.ropec + 2049 * 32;
    const int lo = args.ph_lo, hi = args.ph_hi;
#ifndef PH_MASK
#define PH_MASK 0xffff
#endif
#define IN(k) (((PH_MASK >> (k)) & 1) && lo <= (k) && (k) < hi)
#define SEAM(k) do { if (IN(k) && IN((k) + 1)) { asm volatile("s_waitcnt vmcnt(0) lgkmcnt(0)" ::: "memory"); __builtin_amdgcn_fence(__ATOMIC_RELEASE, "agent"); asm volatile("s_waitcnt vmcnt(0)" ::: "memory"); \
        grid.sync(); __builtin_amdgcn_fence(__ATOMIC_ACQUIRE, "agent"); asm volatile("s_waitcnt vmcnt(0)" ::: "memory"); __syncthreads(); } } while (0)
    using pg8::Gemm; using pg8::StaticOrder;

    if (IN(0)) { p0_prologue(F); } SEAM(0);
    if (IN(1)) {
        Gemm g{F.XN, F.Wqkv, NQKV, DM, 129, 0}; StaticOrder S; S.init(129, NQKV, F.G, (int)blockIdx.x);
        pg8::EpiBf16Bias E{F.R1, NQKV, F.in[7]};
        pg8::gemm_phase<pg8::EpiBf16Bias, StaticOrder, true, true>(F.lds, g, S, E);
    } SEAM(1);
    if (IN(2)) {
        for (int u = blockIdx.x; u < 640; u += F.G) {
            if (u < 128) attn_sample_unit(F, u);
            else { const int v = u - 128; attn_prompt_unit(F, v >> 5, (v >> 4) & 1, v & 15); }
        }
    } SEAM(2);
    if (IN(3)) {
        Gemm g{F.XN, F.Wo, DM, DM, 129, 0}; StaticOrder S; S.init(129, DM, F.G, (int)blockIdx.x);
        pg8::EpiRes E{F.in[0], F.in[1], F.out};
#ifdef DBG_COPY
        (void)g; (void)S; (void)E;
        for (int idx = blockIdx.x * 512 + F.tid; idx < (MP + NS) * 128; idx += F.G * 512) { const int i = idx >> 7, c = (idx & 127) * 8; const int r = i < MP ? i : SROW + (i - MP);
            const u32x4 v = *(const u32x4*)(F.OB + (size_t)r * DM + c); float* o = F.out + (size_t)i * DM + c;
            *(f32x4*)o = (f32x4){bflo(v[0]), bfhi(v[0]), bflo(v[1]), bfhi(v[1])}; *(f32x4*)(o + 4) = (f32x4){bflo(v[2]), bfhi(v[2]), bflo(v[3]), bfhi(v[3])}; }
#else
        pg8::gemm_phase<pg8::EpiRes, StaticOrder, true, true>(F.lds, g, S, E);
#endif
    } SEAM(3);
    if (IN(4)) { ln_phase(F, F.in[20], F.in[21], true); } SEAM(4);
#define FFN_PHASES(l, pb) do { \
        if (IN(pb)) { \
            Gemm g{F.XN, F.Wup + (size_t)(l) * NUP * DM, NUP, DM, 134, 1}; StaticOrder S; S.init(134, NUP, F.G, (int)blockIdx.x); \
            pg8::EpiUp E{F.R1, F.in[17] + (size_t)(l) * 3 * FF, F.in[18] + (size_t)(l) * FF, F.in[5] + (size_t)(l) * NS * 2 * FF, F.out + O_CP + (size_t)(l) * NBATCH * 2 * FF, F.out + O_CS + (size_t)(l) * NS * 2 * FF}; \
            pg8::gemm_phase<pg8::EpiUp, StaticOrder, true, true>(F.lds, g, S, E); \
        } SEAM(pb); \
        if (IN((pb) + 1)) { \
            Gemm g{F.R1, F.Wdn + (size_t)(l) * DM * FF, DM, FF, 129, 0}; StaticOrder S; S.init(129, DM, F.G, (int)blockIdx.x); \
            pg8::EpiRes E{F.out, F.out + O_YS, F.out}; \
            pg8::gemm_phase<pg8::EpiRes, StaticOrder, true, true>(F.lds, g, S, E); \
        } SEAM((pb) + 1); \
        if (IN((pb) + 2)) { ln_phase(F, F.in[22] + (size_t)(l) * DM, F.in[23] + (size_t)(l) * DM, (l) == 0); } SEAM((pb) + 2); } while (0)
    FFN_PHASES(0, 5);
    if (IN(8)) {
        Gemm g{F.XN, F.Wgin, NGIN, DM, 129, 0}; StaticOrder S; S.init(129, NGIN, F.G, (int)blockIdx.x);
        pg8::EpiGlaIn E{F.R1, F.LA, F.in[13]};
        pg8::gemm_phase<pg8::EpiGlaIn, StaticOrder, true, true>(F.lds, g, S, E);
    } SEAM(8);
    if (IN(9)) {
        for (int u = blockIdx.x; u < 768; u += F.G) {
            if (u < 256) gla_prompt_unit(F, u >> 4, (u >> 2) & 3, u & 3);
            else { const int v = u - 256; gla_sample_unit(F, v >> 2, v & 3); }
        }
    } SEAM(9);
    if (IN(10)) { gla_norm_phase(F); } SEAM(10);
    if (IN(11)) {
        Gemm g{F.XN, F.Wgo, DM, DM, 129, 0}; StaticOrder S; S.init(129, DM, F.G, (int)blockIdx.x);
        pg8::EpiRes E{F.out, F.out + O_YS, F.out};
        pg8::gemm_phase<pg8::EpiRes, StaticOrder, true, true>(F.lds, g, S, E);
    } SEAM(11);
    if (IN(12)) { ln_phase(F, F.in[20] + DM, F.in[21] + DM, true); } SEAM(12);
    FFN_PHASES(1, 13);
#undef FFN_PHASES
#undef IN
#undef SEAM
}

extern "C" void kernel_launch(void* const* d_in, const int* in_sizes, int n_in, void* d_out, int out_size, void* d_ws, size_t ws_size, hipStream_t stream) {
    static int grid = 0;
    if (grid == 0) {
        if (n_in != 24 || out_size != 58900480 || ws_size < WS_END) { fprintf(stderr, "kernel_launch: unexpected shapes (n_in %d out %d ws %zu)\n", n_in, out_size, ws_size); grid = -1; return; }
        int dev = 0, cus = 0, per_cu = 0;
        if (hipGetDevice(&dev) != hipSuccess || hipDeviceGetAttribute(&cus, hipDeviceAttributeMultiprocessorCount, dev) != hipSuccess) { grid = -1; return; }
        if (hipFuncSetAttribute((const void*)mega_fwd, hipFuncAttributeMaxDynamicSharedMemorySize, LDS_BYTES) != hipSuccess) { fprintf(stderr, "kernel_launch: hipFuncSetAttribute failed\n"); grid = -1; return; }
        if (hipOccupancyMaxActiveBlocksPerMultiprocessor(&per_cu, (const void*)mega_fwd, 512, LDS_BYTES) != hipSuccess || per_cu < 1) { fprintf(stderr, "kernel_launch: occupancy query says %d\n", per_cu); per_cu = 1; }
        (void)hipGetLastError();
        grid = cus * 1;
    }
    if (grid < 0) return;
    Args a{};
    for (int i = 0; i < 24; ++i) a.in[i] = (const float*)d_in[i];
    a.out = (float*)d_out; a.ws = (unsigned char*)d_ws;
#if MK_PER_PHASE
    for (int p = 0; p < NPHASE; ++p) { a.ph_lo = p; a.ph_hi = p + 1; hipLaunchKernelGGL(mega_fwd, dim3(grid), dim3(512), LDS_BYTES, stream, a); }
#else
    a.ph_lo = 0; a.ph_hi = NPHASE;
    void* kargs[] = {&a};
    const hipError_t e = hipLaunchCooperativeKernel((const void*)mega_fwd, dim3(grid), dim3(512), kargs, LDS_BYTES, stream);
    if (e != hipSuccess) fprintf(stderr, "kernel_launch: cooperative launch failed: %s (grid %d)\n", hipGetErrorString(e), grid);
#endif
}
```

```cpp
#include <hip/hip_runtime.h>
#include <hip/hip_cooperative_groups.h>
#include <cstdio>
#include <cstdint>
namespace cg = cooperative_groups;

#ifndef MK_PER_PHASE
#define MK_PER_PHASE 0
#endif

constexpr int DM = 1024, NBATCH = 16, SEQ = 2048, MP = NBATCH * SEQ, NS = 128;
constexpr int SROW = 33024;
constexpr int MROWS = 33280;
constexpr int NQKV = 1280, FF = 2816, NUP = 2 * FF, NPROJ = 3072, NGIN = 3584;
constexpr float ALPHA = 1.41421356237f, LN_EPS = 1e-5f, QS_GLA = 0.08838834764831845f;
constexpr size_t O_Y = 0, O_YS = 33554432, O_KP = 33685504, O_VP = 33947648, O_KS = 34209792, O_VS = 36306944, O_GP = 38404096, O_GS = 40501248, O_CP = 57278464, O_CS = 57458688;
constexpr size_t MiB = 1u << 20;
constexpr size_t WS_ROPE = 1 * MiB;
constexpr size_t WS_WQKV = 2 * MiB;
constexpr size_t WS_WO = WS_WQKV + 2621440;
constexpr size_t WS_WUP = WS_WO + 2 * MiB;
constexpr size_t WS_WDN = WS_WUP + 22 * MiB;
constexpr size_t WS_WGIN = WS_WDN + 11 * MiB;
constexpr size_t WS_WGO = WS_WGIN + 7 * MiB;
constexpr size_t WS_XN = 50 * MiB;
constexpr size_t WS_SSQ = 116 * MiB;
constexpr size_t WS_R1 = 119 * MiB;
constexpr size_t WS_LA = WS_R1 + (size_t)MROWS * NPROJ * 2;
constexpr size_t WS_END = WS_LA + (size_t)MROWS * 512 * 4;
static_assert(WS_WGO + 2 * MiB <= WS_XN && WS_XN + (size_t)(MROWS + 8) * DM * 2 <= WS_SSQ && WS_SSQ + (size_t)MROWS * 64 <= WS_R1 && WS_END <= 512 * MiB, "ws map");

constexpr int LDS_BYTES = 147456;

#define LAS __attribute__((address_space(3)))
typedef unsigned short bf16_t;
typedef short bf16x8 __attribute__((ext_vector_type(8)));
typedef float f32x4 __attribute__((ext_vector_type(4)));
typedef float f32x2 __attribute__((ext_vector_type(2)));
typedef unsigned u32x4 __attribute__((ext_vector_type(4)));
typedef unsigned u32x2 __attribute__((ext_vector_type(2)));

typedef __bf16 bf16x2_t __attribute__((ext_vector_type(2)));
__device__ __forceinline__ unsigned cvt_pk_bf16(float lo, float hi) { const f32x2 v = {lo, hi}; return __builtin_bit_cast(unsigned, __builtin_convertvector(v, bf16x2_t)); }
__device__ __forceinline__ float bflo(unsigned w) { return __uint_as_float(w << 16); }
__device__ __forceinline__ float bfhi(unsigned w) { return __uint_as_float(w & 0xffff0000u); }
__device__ __forceinline__ float bf2f(bf16_t h) { return __uint_as_float((unsigned)h << 16); }
__device__ __forceinline__ bf16_t f2bf(float f) { return (bf16_t)(cvt_pk_bf16(f, 0.f) & 0xffffu); }
__device__ __forceinline__ bf16x8 mk8(unsigned a, unsigned b, unsigned c, unsigned d) { u32x4 v = {a, b, c, d}; return __builtin_bit_cast(bf16x8, v); }
__device__ __forceinline__ f32x4 mfma16(bf16x8 a, bf16x8 b, f32x4 c) { return __builtin_amdgcn_mfma_f32_16x16x32_bf16(a, b, c, 0, 0, 0); }
__device__ __forceinline__ bool row_valid(int r) { return r < MP || (r >= SROW && r < SROW + NS); }
__device__ __forceinline__ size_t xy_off(int r) { return (size_t)(r < MP ? r : r - (SROW - MP)) * DM; }

namespace pg8 {
#define PG8_LAS __attribute__((address_space(3)))
constexpr int BM = 256, BK = 64, HALF = 128, HTB = HALF * BK * 2, STAGE_BYTES = 8 * HTB, NXCD = 8, WGM = 8;
__host__ __device__ __forceinline__ int lds_byte(int r, int c) { const int st = (r >> 4) * 2 + (c >> 5), rr = r & 15, cc = c & 31, ob = rr * 64 + cc * 2; return st * 1024 + (ob ^ (((ob >> 9) & 1) << 5)); }
__host__ __device__ __forceinline__ void stage_rc(int b, int& R, int& C) { const int st = b / 1024, sb = b % 1024, swz = sb ^ (((sb >> 9) & 1) << 5); R = (st >> 1) * 16 + swz / 64; C = (st & 1) * 32 + (swz % 64) / 2; }
__host__ __device__ __forceinline__ int perm32(int rho) { const int n = rho >> 4, i = rho & 15; return 8 * (i >> 2) + 4 * n + (i & 3); }

struct Unit { int pm, pn; };
struct Gemm { const bf16_t* A; const bf16_t* Bt; int N, K, nM, mode; };
__device__ __forceinline__ int tile_row0(int pm) { return 256 * (pm < 128 ? pm : 129); }
__device__ __forceinline__ int tile_base1(int pm) { return pm < 133 ? 248 * pm : SROW; }
__device__ __forceinline__ const char* abase(const Gemm& g, int pm) {
    const long row = g.mode ? (long)tile_base1(pm) - 2 : (long)tile_row0(pm);
    return (const char*)g.A + row * (long)g.K * 2;
}

struct StaticOrder {
    int nM, nN, nwg, G, c;
    __host__ __device__ void init(int nM_, int N, int G_, int c_) { nM = nM_; nN = N / BM; nwg = nM * nN; G = G_; c = c_; }
    __host__ __device__ bool next(int i, Unit& u) const {
        const long L = (long)i * G + c; if (L >= nwg) return false;
        int wgid = (int)L; { const int q = nwg / NXCD, r = nwg % NXCD, xcd = wgid % NXCD, off = wgid / NXCD; wgid = (xcd < r ? xcd * (q + 1) : r * (q + 1) + (xcd - r) * q) + off; }
        const int nig = WGM * nN, gid = wgid / nig, fm = gid * WGM, gsz = (nM - fm) < WGM ? (nM - fm) : WGM;
        u.pm = fm + ((wgid % nig) % gsz); u.pn = (wgid % nig) / gsz; return true;
    }
    __device__ __forceinline__ void a_ready(const Unit&) const {}
    __device__ __forceinline__ void done(const Unit&) const {}
};

__device__ __forceinline__ f32x2 gelu_pk(f32x2 v) {
    const f32x2 av = __builtin_elementwise_abs(v), d = av * 0.2316418882f + 1.0f;
    f32x2 t; t.x = __builtin_amdgcn_rcpf(d.x); t.y = __builtin_amdgcn_rcpf(d.y);
    f32x2 q = t * 0.5307027145f + (-0.7265760135f); q = q * t + 0.7107068705f; q = q * t + (-0.142248368f); q = q * t + 0.127414796f; q = q * t;
    const f32x2 s = (v * v) * (-0.72134752044f);
    f32x2 e; e.x = __builtin_amdgcn_exp2f(s.x); e.y = __builtin_amdgcn_exp2f(s.y);
    const f32x2 m = v * (q * e), r = v - m;
    f32x2 o; o.x = v.x < 0.f ? m.x : r.x; o.y = v.y < 0.f ? m.y : r.y; return o;
}

struct EpiBf16Bias {
    static constexpr bool PERM = true, AFTER_DRAIN = false;
    bf16_t* O; int ldc; const float* bias;
    __device__ __forceinline__ void operator()(const f32x4 (&acc)[2][2][4][2], const Unit& u, int wr, int wc, int fr, int fq) const {
        const int row0 = tile_row0(u.pm) + wr * 64 + fr, col0 = u.pn * BM + wc * 32 + 8 * fq;
        f32x4 bv[2][2];
#pragma unroll
        for (int bj = 0; bj < 2; ++bj)
#pragma unroll
            for (int n = 0; n < 2; ++n) bv[bj][n] = *(const f32x4*)(bias + col0 + bj * HALF + 4 * n);
#pragma unroll
        for (int ai = 0; ai < 2; ++ai)
#pragma unroll
            for (int m = 0; m < 4; ++m) { bf16_t* rowp = O + (size_t)(row0 + ai * HALF + m * 16) * ldc + col0;
#pragma unroll
                for (int bj = 0; bj < 2; ++bj) { const f32x4 v0 = acc[ai][bj][m][0] + bv[bj][0], v1 = acc[ai][bj][m][1] + bv[bj][1];
                    u32x4 w; w.x = cvt_pk_bf16(v0[0], v0[1]); w.y = cvt_pk_bf16(v0[2], v0[3]); w.z = cvt_pk_bf16(v1[0], v1[1]); w.w = cvt_pk_bf16(v1[2], v1[3]);
                    *(u32x4*)(rowp + bj * HALF) = w; } }
    }
};
template <bool RESBF> struct EpiRes {
    static constexpr bool PERM = true, AFTER_DRAIN = false;
    const float* resP; const float* resS; const bf16_t* resB; bf16_t* out;
    __device__ __forceinline__ void operator()(const f32x4 (&acc)[2][2][4][2], const Unit& u, int wr, int wc, int fr, int fq) const {
        const int rb = tile_row0(u.pm) + wr * 64 + fr, col0 = u.pn * BM + wc * 32 + 8 * fq;
#pragma unroll
        for (int ai = 0; ai < 2; ++ai)
#pragma unroll
            for (int m = 0; m < 4; ++m) { const int r = rb + ai * HALF + m * 16;
                if (row_valid(r)) {
                    bf16_t* op = out + (size_t)r * DM + col0;
#pragma unroll
                    for (int bj = 0; bj < 2; ++bj) { f32x4 x0, x1;
                        if (RESBF) { const u32x4 rv = *(const u32x4*)(resB + (size_t)r * DM + col0 + bj * HALF);
                            x0 = (f32x4){bflo(rv[0]), bfhi(rv[0]), bflo(rv[1]), bfhi(rv[1])}; x1 = (f32x4){bflo(rv[2]), bfhi(rv[2]), bflo(rv[3]), bfhi(rv[3])}; }
                        else { const float* rp = (r < MP ? resP + (size_t)r * DM : resS + (size_t)(r - SROW) * DM) + col0 + bj * HALF; x0 = *(const f32x4*)rp; x1 = *(const f32x4*)(rp + 4); }
                        const f32x4 y0 = x0 * ALPHA + acc[ai][bj][m][0], y1 = x1 * ALPHA + acc[ai][bj][m][1];
                        *(u32x4*)(op + bj * HALF) = (u32x4){cvt_pk_bf16(y0[0], y0[1]), cvt_pk_bf16(y0[2], y0[3]), cvt_pk_bf16(y1[0], y1[1]), cvt_pk_bf16(y1[2], y1[3])}; } } }
    }
};
struct EpiGlaIn {
    static constexpr bool PERM = true, AFTER_DRAIN = false;
    bf16_t* P; float* LA; const float* ba;
    __device__ __forceinline__ void operator()(const f32x4 (&acc)[2][2][4][2], const Unit& u, int wr, int wc, int fr, int fq) const {
        const int row0 = tile_row0(u.pm) + wr * 64 + fr;
        if (u.pn < 12) {
            const int col0 = u.pn * BM + wc * 32 + 8 * fq;
#pragma unroll
            for (int ai = 0; ai < 2; ++ai)
#pragma unroll
                for (int m = 0; m < 4; ++m) { bf16_t* rowp = P + (size_t)(row0 + ai * HALF + m * 16) * NPROJ + col0;
#pragma unroll
                    for (int bj = 0; bj < 2; ++bj) { const f32x4 v0 = acc[ai][bj][m][0], v1 = acc[ai][bj][m][1];
                        u32x4 w; w.x = cvt_pk_bf16(v0[0], v0[1]); w.y = cvt_pk_bf16(v0[2], v0[3]); w.z = cvt_pk_bf16(v1[0], v1[1]); w.w = cvt_pk_bf16(v1[2], v1[3]);
                        *(u32x4*)(rowp + bj * HALF) = w; } }
        } else {
            const int col0 = (u.pn - 12) * BM + wc * 32 + 8 * fq;
#pragma unroll
            for (int bj = 0; bj < 2; ++bj)
#pragma unroll
                for (int n = 0; n < 2; ++n) { const f32x4 bv = *(const f32x4*)(ba + col0 + bj * HALF + 4 * n);
#pragma unroll
                    for (int ai = 0; ai < 2; ++ai)
#pragma unroll
                        for (int m = 0; m < 4; ++m) { const f32x4 z = acc[ai][bj][m][n] + bv; f32x4 o;
#pragma unroll
                            for (int e = 0; e < 4; ++e) o[e] = -(fmaxf(-z[e], 0.f) + __logf(1.f + __expf(-fabsf(z[e])))) * 0.0625f;
                            *(f32x4*)(LA + (size_t)(row0 + ai * HALF + m * 16) * 512 + col0 + bj * HALF + 4 * n) = o; } }
        }
    }
};
__device__ __forceinline__ float dpp_ror1(float v) { return __int_as_float(__builtin_amdgcn_update_dpp(0, __float_as_int(v), 0x121, 0xf, 0xf, false)); }
__device__ __forceinline__ float dpp_ror2(float v) { return __int_as_float(__builtin_amdgcn_update_dpp(0, __float_as_int(v), 0x122, 0xf, 0xf, false)); }
struct EpiUp {
    static constexpr bool PERM = true, AFTER_DRAIN = false;
    bf16_t* G; const float* cw; const float* cb; const float* sconv; float* ocp; float* ocs;
    __device__ __forceinline__ void operator()(const f32x4 (&acc)[2][2][4][2], const Unit& u, int wr, int wc, int fr, int fq) const {
        const int B = tile_base1(u.pm); const bool samp = (u.pm >= 133);
#pragma unroll
        for (int n = 0; n < 2; ++n) {
            const int f = u.pn * HALF + wc * 32 + 8 * fq + 4 * n;
            const f32x4 w0 = *(const f32x4*)(cw + f), w1 = *(const f32x4*)(cw + FF + f), w2 = *(const f32x4*)(cw + 2 * FF + f), bb = *(const f32x4*)(cb + f);
#pragma unroll
            for (int ai = 0; ai < 2; ++ai) {
                const int seg = 2 * ai + wr;
                f32x4 p1 = {0.f, 0.f, 0.f, 0.f}, p2 = {0.f, 0.f, 0.f, 0.f};
#pragma unroll
                for (int m = 0; m < 4; ++m) {
                    const f32x4 a = acc[ai][0][m][n], uu = acc[ai][1][m][n];
                    f32x4 a1, a2;
#pragma unroll
                    for (int e = 0; e < 4; ++e) { a1[e] = dpp_ror1(a[e]); a2[e] = dpp_ror2(a[e]); }
                    f32x4 s1, s2;
#pragma unroll
                    for (int e = 0; e < 4; ++e) { s1[e] = fr >= 1 ? a1[e] : p1[e]; s2[e] = fr >= 2 ? a2[e] : p2[e]; }
                    p1 = a1; p2 = a2;
                    const int j = 16 * m + fr, r = B + 62 * seg + j - 2;
                    bool doit;
                    if (!samp) {
                        doit = (j >= 2) && (r < MP);
                        const int tt = r & (SEQ - 1);
                        if (tt < 1) s1 = (f32x4){0.f, 0.f, 0.f, 0.f};
                        if (tt < 2) s2 = (f32x4){0.f, 0.f, 0.f, 0.f};
                        if (doit && tt >= SEQ - 2) *(f32x4*)(ocp + ((size_t)(r >> 11) * 2 + (tt - (SEQ - 2))) * FF + f) = a;
                    } else {
                        doit = (j >= 2) && (r < SROW + NS);
                        if (doit) { const int bs = r - SROW;
                            s2 = *(const f32x4*)(sconv + ((size_t)bs * 2 + 0) * FF + f); s1 = *(const f32x4*)(sconv + ((size_t)bs * 2 + 1) * FF + f);
                            *(f32x4*)(ocs + ((size_t)bs * 2 + 0) * FF + f) = s1; *(f32x4*)(ocs + ((size_t)bs * 2 + 1) * FF + f) = a; }
                    }
                    if (doit) {
                        const f32x4 c = bb + w0 * s2 + w1 * s1 + w2 * a;
                        const f32x2 g0 = gelu_pk((f32x2){c[0], c[1]}), g1 = gelu_pk((f32x2){c[2], c[3]});
                        u32x2 w; w.x = cvt_pk_bf16(g0.x * uu[0], g0.y * uu[1]); w.y = cvt_pk_bf16(g1.x * uu[2], g1.y * uu[3]);
                        *(u32x2*)(G + (size_t)r * FF + f) = w;
                    }
                }
            }
        }
    }
};

template <class Epi, class Sched, bool ALIGN_EPI = false, bool SP2 = false>
__device__ __forceinline__ void gemm_phase(PG8_LAS unsigned char* lds, const Gemm g, const Sched& S, const Epi& E) {
    const int tid = threadIdx.x, wid = __builtin_amdgcn_readfirstlane(tid >> 6), lane = tid & 63, wr = wid >> 2, wc = wid & 3, fr = lane & 15, fq = lane >> 4;
    const int K = g.K, nt = K / BK;
    unsigned voffA[2], voffB[2];
#pragma unroll
    for (int i = 0; i < 2; ++i) { int R, C; stage_rc(tid * 16 + i * 8192, R, C); const int Rb = Epi::PERM ? ((R & ~31) + perm32(R & 31)) : R;
        voffA[i] = (unsigned)((g.mode ? (R - 2 * (R >> 6)) : R) * K + C) * 2u; voffB[i] = (unsigned)(Rb * K + C) * 2u; }
    const size_t kstep = (size_t)(BK * 2);
    const size_t hstep = (size_t)HALF * K * 2;
    const size_t tstep = 2 * hstep; const size_t hsA = g.mode ? (size_t)124 * K * 2 : hstep;
    const unsigned ldsw = (unsigned)wid * 1024u;
    const int aoff = lds_byte(wr * 64 + fr, fq * 8), boff = lds_byte(wc * 32 + fr, fq * 8);
#define PG8_SA(b, h) (((b) * 2 + (h)) * HTB)
#define PG8_SB(b, h) ((4 + (b) * 2 + (h)) * HTB)
#define PG8_STAGE(bufoff, gbase, voff) do { _Pragma("unroll") for (int _i = 0; _i < 2; ++_i) \
        __builtin_amdgcn_global_load_lds((const unsigned*)((const char*)(gbase) + (voff)[_i]), (PG8_LAS unsigned*)(lds + (bufoff) + ldsw + _i * 8192), 16, 0, 0); } while (0)
#define PG8_LDA(dst, b, h) do { _Pragma("unroll") for (int m = 0; m < 4; ++m) _Pragma("unroll") for (int k = 0; k < 2; ++k) dst[m][k] = *(const PG8_LAS bf16x8*)(lds + PG8_SA(b, h) + aoff + m * 2048 + k * 1024); } while (0)
#define PG8_LDB(dst, b, h) do { _Pragma("unroll") for (int n = 0; n < 2; ++n) _Pragma("unroll") for (int k = 0; k < 2; ++k) dst[n][k] = *(const PG8_LAS bf16x8*)(lds + PG8_SB(b, h) + boff + n * 2048 + k * 1024); } while (0)
#define PG8_MMA(ai, bj, At, Bt) do { __builtin_amdgcn_s_setprio(1); _Pragma("unroll") for (int m = 0; m < 4; ++m) _Pragma("unroll") for (int n = 0; n < 2; ++n) _Pragma("unroll") for (int k = 0; k < 2; ++k) \
        acc[ai][bj][m][n] = __builtin_amdgcn_mfma_f32_16x16x32_bf16(Bt[n][k], At[m][k], acc[ai][bj][m][n], 0, 0, 0); __builtin_amdgcn_s_setprio(0); } while (0)
#define PG8_WAIT_V(n) asm volatile("s_waitcnt vmcnt(" #n ")" ::: "memory")
#define PG8_WAIT_L(n) asm volatile("s_waitcnt lgkmcnt(" #n ")" ::: "memory")
#define PG8_BAR __builtin_amdgcn_s_barrier()
#define PG8_SCHED __builtin_amdgcn_sched_barrier(0)
    Unit cur, nxt; int ui = 0;
    if (!S.next(0, cur)) return;
    f32x4 acc[2][2][4][2];
#pragma unroll
    for (int a = 0; a < 2; ++a)
#pragma unroll
        for (int b = 0; b < 2; ++b)
#pragma unroll
            for (int m = 0; m < 4; ++m)
#pragma unroll
                for (int n = 0; n < 2; ++n) acc[a][b][m][n] = (f32x4){0.f, 0.f, 0.f, 0.f};
    bf16x8 At[4][2], B0[2][2], B1[2][2];
    const char* cA = abase(g, cur.pm); const char* cB = (const char*)g.Bt + (size_t)cur.pn * tstep;
    S.a_ready(cur);
    if constexpr (SP2) {
        PG8_STAGE(PG8_SB(0, 0), cB, voffB); PG8_STAGE(PG8_SB(0, 1), cB + hstep, voffB); PG8_STAGE(PG8_SA(0, 0), cA, voffA); PG8_STAGE(PG8_SA(0, 1), cA + hsA, voffA);
        if (wr == 1) PG8_BAR;
        PG8_WAIT_V(2); PG8_BAR;
        PG8_STAGE(PG8_SB(1, 0), cB + kstep, voffB); PG8_STAGE(PG8_SA(1, 0), cA + kstep, voffA); PG8_STAGE(PG8_SB(1, 1), cB + hstep + kstep, voffB);
        PG8_WAIT_V(6); PG8_BAR;
    } else {
        PG8_STAGE(PG8_SB(0, 0), cB, voffB); PG8_STAGE(PG8_SA(0, 0), cA, voffA); PG8_STAGE(PG8_SB(0, 1), cB + hstep, voffB); PG8_STAGE(PG8_SA(0, 1), cA + hsA, voffA);
        if (wr == 1) PG8_BAR;
        PG8_WAIT_V(4); PG8_BAR;
        PG8_STAGE(PG8_SB(1, 0), cB + kstep, voffB); PG8_STAGE(PG8_SA(1, 0), cA + kstep, voffA); PG8_STAGE(PG8_SB(1, 1), cB + hstep + kstep, voffB);
        PG8_WAIT_V(6); PG8_BAR;
    }
    for (;;) {
        const bool has_next = S.next(ui + 1, nxt);
        const char* nA = has_next ? abase(g, nxt.pm) : cA; const char* nB = has_next ? (const char*)g.Bt + (size_t)nxt.pn * tstep : cB;
        for (int t = 0; t < nt; t += 2) {
            const bool last = (t == nt - 2);
            const char* a1 = cA + (size_t)(t + 1) * kstep;
            const char* a2 = last ? nA : cA + (size_t)(t + 2) * kstep; const char* b2 = last ? nB : cB + (size_t)(t + 2) * kstep;
            const char* a3 = a2 + kstep; const char* b3 = b2 + kstep;
            if (last && has_next) S.a_ready(nxt);
            if constexpr (SP2) {
            PG8_LDB(B0, 0, 0); PG8_LDB(B1, 0, 1); PG8_SCHED; PG8_LDA(At, 0, 0); PG8_STAGE(PG8_SA(1, 1), a1 + hsA, voffA);
            PG8_WAIT_V(8); PG8_WAIT_L(0); PG8_BAR; PG8_MMA(0, 0, At, B0); PG8_MMA(0, 1, At, B1); PG8_BAR; PG8_SCHED;
            PG8_LDA(At, 0, 1); PG8_STAGE(PG8_SB(0, 0), b2, voffB); PG8_STAGE(PG8_SB(0, 1), b2 + hstep, voffB); PG8_STAGE(PG8_SA(0, 0), a2, voffA);
            PG8_WAIT_V(8); PG8_WAIT_L(0); PG8_BAR; PG8_MMA(1, 0, At, B0); PG8_MMA(1, 1, At, B1); PG8_BAR; PG8_SCHED;
            PG8_LDB(B0, 1, 0); PG8_LDB(B1, 1, 1); PG8_SCHED; PG8_LDA(At, 1, 0); PG8_STAGE(PG8_SA(0, 1), a2 + hsA, voffA);
            PG8_WAIT_V(8); PG8_WAIT_L(0); PG8_BAR; PG8_MMA(0, 0, At, B0); PG8_MMA(0, 1, At, B1); PG8_BAR; PG8_SCHED;
            PG8_LDA(At, 1, 1); PG8_STAGE(PG8_SB(1, 0), b3, voffB); PG8_STAGE(PG8_SB(1, 1), b3 + hstep, voffB); PG8_STAGE(PG8_SA(1, 0), a3, voffA);
            PG8_WAIT_V(8); PG8_WAIT_L(0); PG8_BAR; PG8_MMA(1, 0, At, B0); PG8_MMA(1, 1, At, B1); PG8_BAR; PG8_SCHED;
            } else {
            PG8_LDB(B0, 0, 0); PG8_SCHED; PG8_LDA(At, 0, 0); PG8_STAGE(PG8_SA(1, 1), a1 + hsA, voffA);
            PG8_WAIT_L(8); PG8_BAR; PG8_WAIT_L(0); PG8_MMA(0, 0, At, B0); PG8_BAR; PG8_SCHED;
            PG8_LDB(B1, 0, 1); PG8_STAGE(PG8_SB(0, 0), b2, voffB);
            PG8_BAR; PG8_WAIT_L(0); PG8_MMA(0, 1, At, B1); PG8_BAR;
            PG8_LDA(At, 0, 1); PG8_STAGE(PG8_SA(0, 0), a2, voffA);
            PG8_BAR; PG8_WAIT_L(0); PG8_MMA(1, 0, At, B0); PG8_BAR; PG8_SCHED;
            PG8_STAGE(PG8_SB(0, 1), b2 + hstep, voffB);
            PG8_WAIT_V(6); PG8_BAR; PG8_MMA(1, 1, At, B1); PG8_BAR;
            PG8_LDB(B0, 1, 0); PG8_SCHED; PG8_LDA(At, 1, 0); PG8_STAGE(PG8_SA(0, 1), a2 + hsA, voffA);
            PG8_WAIT_L(8); PG8_BAR; PG8_WAIT_L(0); PG8_MMA(0, 0, At, B0); PG8_BAR; PG8_SCHED;
            PG8_LDB(B1, 1, 1); PG8_STAGE(PG8_SB(1, 0), b3, voffB);
            PG8_BAR; PG8_WAIT_L(0); PG8_MMA(0, 1, At, B1); PG8_BAR;
            PG8_LDA(At, 1, 1); PG8_STAGE(PG8_SA(1, 0), a3, voffA);
            PG8_BAR; PG8_WAIT_L(0); PG8_MMA(1, 0, At, B0); PG8_BAR; PG8_SCHED;
            PG8_STAGE(PG8_SB(1, 1), b3 + hstep, voffB);
            PG8_WAIT_V(6); PG8_BAR; PG8_MMA(1, 1, At, B1); PG8_BAR;
            }
        }
        if constexpr (ALIGN_EPI) { if (wr == 0) PG8_BAR; }
        if constexpr (!Epi::AFTER_DRAIN) { E(acc, cur, wr, wc, fr, fq); S.done(cur); }
        if (!has_next) break;
#pragma unroll
        for (int a = 0; a < 2; ++a)
#pragma unroll
            for (int b = 0; b < 2; ++b)
#pragma unroll
                for (int m = 0; m < 4; ++m)
#pragma unroll
                    for (int n = 0; n < 2; ++n) acc[a][b][m][n] = (f32x4){0.f, 0.f, 0.f, 0.f};
        cur = nxt; cA = nA; cB = nB; ++ui;
        if constexpr (ALIGN_EPI) { if (wr == 1) PG8_BAR; }
    }
    PG8_WAIT_V(0);
    if constexpr (!ALIGN_EPI) { if (wr == 0) PG8_BAR; }
    PG8_BAR;
    if constexpr (Epi::AFTER_DRAIN) { E.fused(acc, cur, wr, wc, fr, fq, lds, wid, lane); S.done(cur); }
#undef PG8_SA
#undef PG8_SB
#undef PG8_STAGE
#undef PG8_LDA
#undef PG8_LDB
#undef PG8_MMA
#undef PG8_WAIT_V
#undef PG8_WAIT_L
#undef PG8_BAR
#undef PG8_SCHED
}
}

struct Frame {
    LAS unsigned char* lds;
    int tid, lane, wave, G;
    const float* in[24];
    float* out;
    bf16_t *Wqkv, *Wo, *Wup, *Wdn, *Wgin, *Wgo;
    bf16_t *XN, *OB, *YB;
    bf16_t *R1;
    float *LA, *SSQ, *ropec, *ropes;
};
__device__ __forceinline__ float wave_sum(float v) {
#pragma unroll
    for (int o = 1; o < 64; o <<= 1) v += __shfl_xor(v, o);
    return v;
}
__device__ __forceinline__ float wave_max(float v) {
#pragma unroll
    for (int o = 1; o < 64; o <<= 1) v = fmaxf(v, __shfl_xor(v, o));
    return v;
}
#define LDS_WAIT() asm volatile("s_waitcnt lgkmcnt(0)" ::: "memory")


#define GAS __attribute__((address_space(1)))
#define RLX_AGENT __ATOMIC_RELAXED, __HIP_MEMORY_SCOPE_AGENT
#define XB_TMO      128
#define XB_XCNT(j)  (256  + 64 * (j))
#define XB_XSUB(j)  (1280 + 64 * (j))
#define XB_XGEN(j)  (2304 + 64 * (j))
#define XB_TOP      3328
#define XB_TOPGEN   3392
#define XCD_BAR_WORDS 3456
#define XB_SPIN_CAP (1u << 18)

__device__ __forceinline__ unsigned xb_ld(unsigned* p)              { return __hip_atomic_load(p, __ATOMIC_RELAXED, __HIP_MEMORY_SCOPE_AGENT); }
__device__ __forceinline__ unsigned xb_add(unsigned* p, unsigned v) { return __hip_atomic_fetch_add(p, v, __ATOMIC_RELAXED, __HIP_MEMORY_SCOPE_AGENT); }
__device__ __forceinline__ unsigned xb_xcc_id() { return (unsigned)__builtin_amdgcn_s_getreg((3 << 11) | 20) & 0xFu; }
#define XB_SPIN(cond, bar) do { unsigned _sp = 0; while (cond) { __builtin_amdgcn_s_sleep(1); \
    if ((++_sp & 255u) == 0u) { if (xb_ld(&(bar)[XB_TMO])) break; if (_sp > XB_SPIN_CAP) { atomicAdd(&(bar)[XB_TMO], 1u); break; } } } } while (0)

struct XcdBarrier {
    unsigned* bar; unsigned x;
    volatile LAS unsigned* st;
};

__device__ __forceinline__ XcdBarrier xcd_barrier_post(unsigned* bar, volatile LAS unsigned* st) {
    XcdBarrier b; b.bar = bar; b.x = xb_xcc_id(); b.st = st;
    if (threadIdx.x == 0) (void)xb_add(&bar[XB_XCNT(b.x)], 1u);
    return b;
}
__device__ __forceinline__ void xcd_barrier_complete(unsigned* bar, unsigned x, unsigned& nloc, unsigned& nx) {
    const unsigned G = gridDim.x * gridDim.y * gridDim.z;
    unsigned sum, cnt, mine, sp = 0u;
    for (;;) {
        sum = 0u; cnt = 0u; mine = 0u;
#pragma unroll
        for (unsigned j = 0; j < 16; ++j) { const unsigned c = xb_ld(&bar[XB_XCNT(j)]); sum += c; cnt += (c > 0u) ? 1u : 0u; mine = (j == x) ? c : mine; }
        if (sum == G) break;
        __builtin_amdgcn_s_sleep(1);
        if ((++sp & 255u) == 0u) { if (xb_ld(&bar[XB_TMO])) break; if (sp > XB_SPIN_CAP) { atomicAdd(&bar[XB_TMO], 1u); break; } }
    }
    nloc = mine > 0u ? mine : 1u; nx = cnt > 0u ? cnt : 1u;
}

__device__ __forceinline__ void xcd_barrier(const XcdBarrier& b) {
    asm volatile("s_waitcnt vmcnt(0)" ::: "memory");
    __syncthreads();
    if (threadIdx.x == 0) {
        unsigned* bar = b.bar;
        __builtin_amdgcn_s_waitcnt(0);
        unsigned nloc = b.st[0], nx = b.st[1];
        if (nloc == 0u) { xcd_barrier_complete(bar, b.x, nloc, nx); b.st[0] = nloc; b.st[1] = nx; }
        const unsigned old = xb_add(&bar[XB_XSUB(b.x)], 1u);
        const unsigned gen = old / nloc;
        if (old + 1u == (gen + 1u) * nloc) {
            __builtin_amdgcn_fence(__ATOMIC_RELEASE, "agent");
            asm volatile("s_waitcnt vmcnt(0)" ::: "memory");
            const unsigned og = xb_add(&bar[XB_TOP], 1u);
            const unsigned tg = og / nx;
            if (og + 1u == (tg + 1u) * nx) xb_add(&bar[XB_TOPGEN], 1u);
            else XB_SPIN(xb_ld(&bar[XB_TOPGEN]) == tg, bar);
            __builtin_amdgcn_fence(__ATOMIC_ACQUIRE, "agent");
            xb_add(&bar[XB_XGEN(b.x)], 1u);
            asm volatile("s_waitcnt vmcnt(0)" ::: "memory");
        } else {
            XB_SPIN(xb_ld(&bar[XB_XGEN(b.x)]) == gen, bar);
            __builtin_amdgcn_fence(__ATOMIC_ACQUIRE, "agent");
            asm volatile("s_waitcnt vmcnt(0)" ::: "memory");
        }
    }
    __syncthreads();
}
__device__ __forceinline__ void p0_transpose_item(const float* W, int K, int N, bf16_t* WT, int up, LAS float* scr, int item, int lane) {
    const int nblk = N / 32, kb = item / nblk, nb = item % nblk, k0 = 64 * kb, n0 = 32 * nb;
#pragma unroll 16
    for (int i = 0; i < 32; ++i) { const int kk = 2 * i + (lane >> 5); scr[kk * 33 + (lane & 31)] = W[(size_t)(k0 + kk) * N + n0 + (lane & 31)]; }
    LDS_WAIT(); asm volatile("" ::: "memory");
    int r0 = n0;
    if (up) { const int hi = n0 >= FF, c = n0 - hi * FF; r0 = 256 * (c >> 7) + 128 * hi + (c & 127); }
    const int c = lane & 7;
#pragma unroll
    for (int j = 0; j < 4; ++j) { const int n = (lane >> 3) + 8 * j; const LAS float* s = scr + (8 * c) * 33 + n;
        u32x4 o; o.x = cvt_pk_bf16(s[0 * 33], s[1 * 33]); o.y = cvt_pk_bf16(s[2 * 33], s[3 * 33]); o.z = cvt_pk_bf16(s[4 * 33], s[5 * 33]); o.w = cvt_pk_bf16(s[6 * 33], s[7 * 33]);
        *(u32x4*)(WT + (size_t)(r0 + n) * K + k0 + 8 * c) = o; }
    LDS_WAIT(); asm volatile("" ::: "memory");
}
__device__ __forceinline__ void p0_prologue(const Frame& F) {
    LAS float* scr = (LAS float*)(F.lds + F.wave * 16384);
    const int gw = blockIdx.x * 8 + F.wave, NGW = F.G * 8;
    constexpr int I_QKV = 16 * 40, I_O = 16 * 32, I_GIN = 16 * 96, I_UP = 16 * 176, I_DN = 44 * 32;
    constexpr int NITEMS = I_QKV + 2 * I_O + I_GIN + 2 * I_UP + 2 * I_DN;
    for (int it = gw; it < NITEMS; it += NGW) {
        int r = it;
        if (r < I_QKV) { p0_transpose_item(F.in[6], DM, NQKV, F.Wqkv, 0, scr, r, F.lane); continue; } r -= I_QKV;
        if (r < I_O) { p0_transpose_item(F.in[9], DM, DM, F.Wo, 0, scr, r, F.lane); continue; } r -= I_O;
        if (r < I_O) { p0_transpose_item(F.in[15], DM, DM, F.Wgo, 0, scr, r, F.lane); continue; } r -= I_O;
        if (r < I_GIN) { p0_transpose_item(F.in[10], DM, NPROJ, F.Wgin, 0, scr, r, F.lane); continue; } r -= I_GIN;
        if (r < 2 * I_UP) { const int l = r / I_UP; p0_transpose_item(F.in[16] + (size_t)l * DM * NUP, DM, NUP, F.Wup + (size_t)l * NUP * DM, 1, scr, r % I_UP, F.lane); continue; } r -= 2 * I_UP;
        { const int l = r / I_DN; p0_transpose_item(F.in[19] + (size_t)l * FF * DM, FF, DM, F.Wdn + (size_t)l * DM * FF, 0, scr, r % I_DN, F.lane); }
    }
    const int gt = blockIdx.x * 512 + F.tid, NGT = F.G * 512;
    for (int idx = gt; idx < 512 * 128; idx += NGT) { const int n = idx >> 7, k0 = (idx & 127) * 8; float s[8];
#pragma unroll
        for (int e = 0; e < 8; ++e) s[e] = 0.f;
        for (int r = 0; r < 16; ++r) { const float w2 = F.in[12][r * 512 + n];
#pragma unroll
            for (int e = 0; e < 8; ++e) s[e] += F.in[11][(k0 + e) * 16 + r] * w2; }
        u32x4 o; o.x = cvt_pk_bf16(s[0], s[1]); o.y = cvt_pk_bf16(s[2], s[3]); o.z = cvt_pk_bf16(s[4], s[5]); o.w = cvt_pk_bf16(s[6], s[7]);
        *(u32x4*)(F.Wgin + (size_t)(NPROJ + n) * DM + k0) = o; }
    for (int idx0 = gt; idx0 < (MP + NS) * 128; idx0 += 4 * NGT) { f32x4 a[4], c[4];
#pragma unroll
        for (int u = 0; u < 4; ++u) { const int idx = idx0 + u * NGT; if (idx < (MP + NS) * 128) { const int i = idx >> 7, cc = (idx & 127) * 8;
            const float* xp = (i < MP ? F.in[0] + (size_t)i * DM : F.in[1] + (size_t)(i - MP) * DM) + cc; a[u] = *(const f32x4*)xp; c[u] = *(const f32x4*)(xp + 4); } }
#pragma unroll
        for (int u = 0; u < 4; ++u) { const int idx = idx0 + u * NGT; if (idx < (MP + NS) * 128) { const int i = idx >> 7, cc = (idx & 127) * 8, r = i < MP ? i : SROW + (i - MP);
            u32x4 o; o.x = cvt_pk_bf16(a[u][0], a[u][1]); o.y = cvt_pk_bf16(a[u][2], a[u][3]); o.z = cvt_pk_bf16(c[u][0], c[u][1]); o.w = cvt_pk_bf16(c[u][2], c[u][3]);
            *(u32x4*)(F.XN + (size_t)r * DM + cc) = o; } }
    }
    for (int idx = gt; idx < 2049 * 32; idx += NGT) { const int p = idx >> 5, i = idx & 31;
        const float inv = (float)(1.0 / pow(10000.0, (double)i / 32.0)); const float pos = p < 2048 ? (float)p : 16384.f; const float ang = pos * inv;
        F.ropec[idx] = (float)cos((double)ang); F.ropes[idx] = (float)sin((double)ang); }
}

__device__ __forceinline__ void ln_phase(const Frame& F, const float* g, const float* b, bool final) {
    const int gw = blockIdx.x * 8 + F.wave, NGW = F.G * 8, lane = F.lane;
    f32x4 gv[4], bv[4];
#pragma unroll
    for (int j = 0; j < 2; ++j) { gv[2 * j] = *(const f32x4*)(g + 8 * lane + 512 * j); gv[2 * j + 1] = *(const f32x4*)(g + 8 * lane + 512 * j + 4); bv[2 * j] = *(const f32x4*)(b + 8 * lane + 512 * j); bv[2 * j + 1] = *(const f32x4*)(b + 8 * lane + 512 * j + 4); }
    for (int i = 2 * gw; i < MP + NS; i += 2 * NGW) {
        u32x4 raw[2][2]; int rr[2];
#pragma unroll
        for (int q = 0; q < 2; ++q) { const int ii = i + q; rr[q] = ii < MP ? ii : SROW + (ii - MP);
            const bf16_t* yp = F.YB + (size_t)rr[q] * DM + 8 * lane; raw[q][0] = *(const u32x4*)yp; raw[q][1] = *(const u32x4*)(yp + 512); }
        f32x4 v[2][4]; float s[2] = {0.f, 0.f};
#pragma unroll
        for (int q = 0; q < 2; ++q)
#pragma unroll
            for (int j = 0; j < 2; ++j) { const u32x4 rw = raw[q][j]; v[q][2 * j] = (f32x4){bflo(rw[0]), bfhi(rw[0]), bflo(rw[1]), bfhi(rw[1])}; v[q][2 * j + 1] = (f32x4){bflo(rw[2]), bfhi(rw[2]), bflo(rw[3]), bfhi(rw[3])}; }
#pragma unroll
        for (int q = 0; q < 2; ++q)
#pragma unroll
            for (int j = 0; j < 4; ++j) s[q] += (v[q][j][0] + v[q][j][1]) + (v[q][j][2] + v[q][j][3]);
#pragma unroll
        for (int o = 1; o < 64; o <<= 1) { s[0] += __shfl_xor(s[0], o); s[1] += __shfl_xor(s[1], o); }
        float s2[2] = {0.f, 0.f};
#pragma unroll
        for (int q = 0; q < 2; ++q) { const float mean = s[q] * (1.f / DM);
#pragma unroll
            for (int j = 0; j < 4; ++j) { v[q][j] = v[q][j] - mean; s2[q] += (v[q][j][0] * v[q][j][0] + v[q][j][1] * v[q][j][1]) + (v[q][j][2] * v[q][j][2] + v[q][j][3] * v[q][j][3]); } }
#pragma unroll
        for (int o = 1; o < 64; o <<= 1) { s2[0] += __shfl_xor(s2[0], o); s2[1] += __shfl_xor(s2[1], o); }
#pragma unroll
        for (int q = 0; q < 2; ++q) { const float rstd = 1.f / sqrtf(s2[q] * (1.f / DM) + LN_EPS);
            f32x4 o[4];
#pragma unroll
            for (int j = 0; j < 4; ++j) o[j] = v[q][j] * rstd * gv[j] + bv[j];
            if (final) { float* row = F.out + (size_t)(i + q) * DM + 8 * lane;
                *(f32x4*)row = o[0]; *(f32x4*)(row + 4) = o[1]; *(f32x4*)(row + 512) = o[2]; *(f32x4*)(row + 516) = o[3]; }
            else { bf16_t* xr = F.XN + (size_t)rr[q] * DM + 8 * lane;
                *(u32x4*)xr = (u32x4){cvt_pk_bf16(o[0][0], o[0][1]), cvt_pk_bf16(o[0][2], o[0][3]), cvt_pk_bf16(o[1][0], o[1][1]), cvt_pk_bf16(o[1][2], o[1][3])};
                *(u32x4*)(xr + 512) = (u32x4){cvt_pk_bf16(o[2][0], o[2][1]), cvt_pk_bf16(o[2][2], o[2][3]), cvt_pk_bf16(o[3][0], o[3][1]), cvt_pk_bf16(o[3][2], o[3][3])}; } }
    }
}

__device__ __forceinline__ void attn_prompt_unit(const Frame& F, int b, int kvh, int qb) {
    LAS bf16_t* Ks = (LAS bf16_t*)F.lds;
    LAS bf16_t* Vt = (LAS bf16_t*)(F.lds + 36864);
    const int tid = F.tid, lane = F.lane, w = F.wave, fr = lane & 15, g = lane >> 4;
    const bf16_t* QKV = F.R1; const bool last = (qb == 15);
#pragma unroll
    for (int rep = 0; rep < 2; ++rep) {
        const int idx = tid + 512 * rep, s = idx >> 2, d0 = 8 * (idx & 3), tk = qb * 128 - 128 + s;
        u32x4 o0 = {0u, 0u, 0u, 0u}, o1 = {0u, 0u, 0u, 0u};
        if (tk >= 0) {
            const bf16_t* kp = QKV + (size_t)(b * SEQ + tk) * NQKV + 1024 + kvh * 64 + d0;
            const u32x4 k0 = *(const u32x4*)kp, k1 = *(const u32x4*)(kp + 32);
            const float* cp = F.ropec + tk * 32 + d0; const float* sp = F.ropes + tk * 32 + d0;
            const f32x4 c0 = *(const f32x4*)cp, c1 = *(const f32x4*)(cp + 4), s0 = *(const f32x4*)sp, s1 = *(const f32x4*)(sp + 4);
            float r0[8], r1[8];
#pragma unroll
            for (int e = 0; e < 4; ++e) {
                const float xa = bflo(k0[e]), xb = bfhi(k0[e]), ya = bflo(k1[e]), yb = bfhi(k1[e]);
                const float ca = e < 2 ? c0[2 * e] : c1[2 * e - 4], cb = e < 2 ? c0[2 * e + 1] : c1[2 * e - 3];
                const float sa = e < 2 ? s0[2 * e] : s1[2 * e - 4], sb = e < 2 ? s0[2 * e + 1] : s1[2 * e - 3];
                r0[2 * e] = xa * ca - ya * sa; r0[2 * e + 1] = xb * cb - yb * sb; r1[2 * e] = ya * ca + xa * sa; r1[2 * e + 1] = yb * cb + xb * sb;
            }
            o0 = (u32x4){cvt_pk_bf16(r0[0], r0[1]), cvt_pk_bf16(r0[2], r0[3]), cvt_pk_bf16(r0[4], r0[5]), cvt_pk_bf16(r0[6], r0[7])};
            o1 = (u32x4){cvt_pk_bf16(r1[0], r1[1]), cvt_pk_bf16(r1[2], r1[3]), cvt_pk_bf16(r1[4], r1[5]), cvt_pk_bf16(r1[6], r1[7])};
            if (last && s >= 128) { float* ko = F.out + O_KP + ((size_t)(b * 128 + s - 128) * 2 + kvh) * 64 + d0;
                *(f32x4*)ko = (f32x4){r0[0], r0[1], r0[2], r0[3]}; *(f32x4*)(ko + 4) = (f32x4){r0[4], r0[5], r0[6], r0[7]};
                *(f32x4*)(ko + 32) = (f32x4){r1[0], r1[1], r1[2], r1[3]}; *(f32x4*)(ko + 36) = (f32x4){r1[4], r1[5], r1[6], r1[7]}; }
        }
        *(LAS u32x4*)(Ks + s * 72 + d0) = o0; *(LAS u32x4*)(Ks + s * 72 + 32 + d0) = o1;
    }
#pragma unroll
    for (int rep = 0; rep < 2; ++rep) {
        const int dp = lane & 31, kq = (lane >> 5) + 2 * w + 16 * rep;
        unsigned vv[8];
#pragma unroll
        for (int i = 0; i < 8; ++i) { const int s = 8 * kq + i, tk = qb * 128 - 128 + s; vv[i] = 0u;
            if (tk >= 0) { vv[i] = *(const unsigned*)(QKV + (size_t)(b * SEQ + tk) * NQKV + 1152 + kvh * 64 + 2 * dp);
                if (last && s >= 128) *(f32x2*)(F.out + O_VP + ((size_t)(b * 128 + s - 128) * 2 + kvh) * 64 + 2 * dp) = (f32x2){bflo(vv[i]), bfhi(vv[i])}; } }
        u32x4 lo, hi;
#pragma unroll
        for (int i = 0; i < 4; ++i) { lo[i] = (vv[2 * i] & 0xffffu) | (vv[2 * i + 1] << 16); hi[i] = (vv[2 * i] >> 16) | (vv[2 * i + 1] & 0xffff0000u); }
        *(LAS u32x4*)(Vt + (2 * dp) * 272 + 8 * kq) = lo; *(LAS u32x4*)(Vt + (2 * dp + 1) * 272 + 8 * kq) = hi;
    }
    __syncthreads();
    constexpr float QSC = 0.125f * 1.4426950408889634f;
    const int h = kvh * 8 + w; const float sink = F.in[8][h] * 1.4426950408889634f;
    u32x4 nq0, nq1; f32x4 nc0, nc1, ns0, ns1;
#define ATT_QLOAD(qg_) do { const int pos_ = qb * 128 + 16 * (qg_) + fr; const bf16_t* qp = QKV + (size_t)(b * SEQ + pos_) * NQKV + h * 64 + 8 * g; nq0 = *(const u32x4*)qp; nq1 = *(const u32x4*)(qp + 32); \
        const float* cp = F.ropec + pos_ * 32 + 8 * g; const float* sp = F.ropes + pos_ * 32 + 8 * g; nc0 = *(const f32x4*)cp; nc1 = *(const f32x4*)(cp + 4); ns0 = *(const f32x4*)sp; ns1 = *(const f32x4*)(sp + 4); } while (0)
    ATT_QLOAD(0);
    for (int qg = 0; qg < 8; ++qg) {
        const int i = 16 * qg + fr, pos = qb * 128 + i; const size_t rq = (size_t)(b * SEQ + pos);
        bf16x8 Bq0, Bq1;
        { const u32x4 q0 = nq0, q1 = nq1; const f32x4 c0 = nc0, c1 = nc1, s0 = ns0, s1 = ns1;
            if (qg < 7) ATT_QLOAD(qg + 1);
            float r0[8], r1[8];
#pragma unroll
            for (int e = 0; e < 4; ++e) {
                const float xa = bflo(q0[e]), xb = bfhi(q0[e]), ya = bflo(q1[e]), yb = bfhi(q1[e]);
                const float ca = e < 2 ? c0[2 * e] : c1[2 * e - 4], cb = e < 2 ? c0[2 * e + 1] : c1[2 * e - 3];
                const float sa = e < 2 ? s0[2 * e] : s1[2 * e - 4], sb = e < 2 ? s0[2 * e + 1] : s1[2 * e - 3];
                r0[2 * e] = (xa * ca - ya * sa) * QSC; r0[2 * e + 1] = (xb * cb - yb * sb) * QSC; r1[2 * e] = (ya * ca + xa * sa) * QSC; r1[2 * e + 1] = (yb * cb + xb * sb) * QSC;
            }
            Bq0 = mk8(cvt_pk_bf16(r0[0], r0[1]), cvt_pk_bf16(r0[2], r0[3]), cvt_pk_bf16(r0[4], r0[5]), cvt_pk_bf16(r0[6], r0[7]));
            Bq1 = mk8(cvt_pk_bf16(r1[0], r1[1]), cvt_pk_bf16(r1[2], r1[3]), cvt_pk_bf16(r1[4], r1[5]), cvt_pk_bf16(r1[6], r1[7])); }
        f32x4 sc[9]; float mx = -1e30f;
#pragma unroll
        for (int tt = 0; tt < 9; ++tt) {
            const LAS bf16_t* kr = Ks + ((qg + tt) * 16 + fr) * 72 + 8 * g;
            f32x4 a = {0.f, 0.f, 0.f, 0.f};
            a = mfma16(*(const LAS bf16x8*)kr, Bq0, a); a = mfma16(*(const LAS bf16x8*)(kr + 32), Bq1, a);
            if (tt == 0) {
#pragma unroll
                for (int e = 0; e < 4; ++e) a[e] = (4 * g + e - fr >= 1) ? a[e] : -1e30f; }
            if (tt == 8) {
#pragma unroll
                for (int e = 0; e < 4; ++e) a[e] = (4 * g + e - fr <= 0) ? a[e] : -1e30f; }
            if (qb == 0 && qg + tt < 8) a = (f32x4){-1e30f, -1e30f, -1e30f, -1e30f};
            mx = fmaxf(fmaxf(mx, fmaxf(a[0], a[1])), fmaxf(a[2], a[3]));
            sc[tt] = a;
        }
        mx = fmaxf(mx, __shfl_xor(mx, 16)); mx = fmaxf(mx, __shfl_xor(mx, 32)); mx = fmaxf(mx, sink);
        float sum = 0.f;
#pragma unroll
        for (int tt = 0; tt < 9; ++tt)
#pragma unroll
            for (int e = 0; e < 4; ++e) { const float p = __builtin_amdgcn_exp2f(sc[tt][e] - mx); sc[tt][e] = p; sum += p; }
        sum += __shfl_xor(sum, 16); sum += __shfl_xor(sum, 32);
        const float inv = 1.f / (sum + __builtin_amdgcn_exp2f(sink - mx));
        bf16x8 P[5];
#pragma unroll
        for (int ks = 0; ks < 5; ++ks) {
            const f32x4 lo = sc[2 * ks]; f32x4 hi = {0.f, 0.f, 0.f, 0.f}; if (2 * ks + 1 < 9) hi = sc[(2 * ks + 1) < 9 ? 2 * ks + 1 : 8];
            P[ks] = mk8(cvt_pk_bf16(lo[0], lo[1]), cvt_pk_bf16(lo[2], lo[3]), cvt_pk_bf16(hi[0], hi[1]), cvt_pk_bf16(hi[2], hi[3]));
        }
        bf16_t* orow = F.XN + rq * DM + h * 64 + 4 * g;
#pragma unroll
        for (int nt = 0; nt < 4; ++nt) {
            const LAS bf16_t* vr = Vt + (16 * nt + fr) * 272 + 4 * g;
            f32x4 o = {0.f, 0.f, 0.f, 0.f};
#pragma unroll
            for (int ks = 0; ks < 5; ++ks) { const int k0 = qg + 2 * ks, k1 = (k0 + 1) < 16 ? (k0 + 1) : 15;
                const u32x2 lo = *(const LAS u32x2*)(vr + k0 * 16), hi = *(const LAS u32x2*)(vr + k1 * 16);
                o = mfma16(mk8(lo.x, lo.y, hi.x, hi.y), P[ks], o); }
            u32x2 wv; wv.x = cvt_pk_bf16(o[0] * inv, o[1] * inv); wv.y = cvt_pk_bf16(o[2] * inv, o[3] * inv);
            *(u32x2*)(orow + 16 * nt) = wv;
        }
    }
#undef ATT_QLOAD
    __syncthreads();
}
__device__ __forceinline__ void attn_sample_unit(const Frame& F, int b) {
    LAS bf16_t* Kc = (LAS bf16_t*)F.lds;
    LAS bf16_t* Vc = (LAS bf16_t*)(F.lds + 34816);
    LAS float* qs = (LAS float*)(F.lds + 69632);
    LAS float* ps = (LAS float*)(F.lds + 73728);
    const int tid = F.tid, lane = F.lane, w = F.wave;
    const float* ck = F.in[2] + (size_t)b * 128 * 128; const float* cv = F.in[3] + (size_t)b * 128 * 128;
    float* nk = F.out + O_KS + (size_t)b * 128 * 128; float* nv = F.out + O_VS + (size_t)b * 128 * 128;
#pragma unroll
    for (int half = 0; half < 2; ++half) { f32x4 kk[4], vv[4];
#pragma unroll
        for (int it = 0; it < 4; ++it) { const int idx = tid + 512 * (4 * half + it); if (idx < 127 * 32) { const int s = 1 + (idx >> 5), c4 = 4 * (idx & 31); kk[it] = *(const f32x4*)(ck + s * 128 + c4); vv[it] = *(const f32x4*)(cv + s * 128 + c4); } }
#pragma unroll
        for (int it = 0; it < 4; ++it) { const int idx = tid + 512 * (4 * half + it); if (idx < 127 * 32) { const int s = 1 + (idx >> 5), c4 = 4 * (idx & 31);
            *(f32x4*)(nk + (s - 1) * 128 + c4) = kk[it]; *(f32x4*)(nv + (s - 1) * 128 + c4) = vv[it];
            *(LAS u32x2*)(Kc + (s - 1) * 136 + c4) = (u32x2){cvt_pk_bf16(kk[it][0], kk[it][1]), cvt_pk_bf16(kk[it][2], kk[it][3])};
            *(LAS u32x2*)(Vc + (s - 1) * 136 + c4) = (u32x2){cvt_pk_bf16(vv[it][0], vv[it][1]), cvt_pk_bf16(vv[it][2], vv[it][3])}; } } }
    const int row = SROW + b; const bf16_t* qrow = F.R1 + (size_t)row * NQKV;
    { const int h = tid >> 5, dd = tid & 31; const float q0 = bf2f(qrow[h * 64 + dd]), q1 = bf2f(qrow[h * 64 + dd + 32]);
        const float c = F.ropec[2048 * 32 + dd], s = F.ropes[2048 * 32 + dd];
        qs[h * 64 + dd] = (q0 * c - q1 * s) * 0.125f; qs[h * 64 + dd + 32] = (q1 * c + q0 * s) * 0.125f; }
    if (tid < 64) { const int kvh = tid >> 5, dd = tid & 31; const float k0 = bf2f(qrow[1024 + kvh * 64 + dd]), k1 = bf2f(qrow[1024 + kvh * 64 + dd + 32]);
        const float c = F.ropec[2048 * 32 + dd], s = F.ropes[2048 * 32 + dd]; const float r0 = k0 * c - k1 * s, r1 = k1 * c + k0 * s;
        nk[127 * 128 + kvh * 64 + dd] = r0; nk[127 * 128 + kvh * 64 + dd + 32] = r1; Kc[127 * 136 + kvh * 64 + dd] = f2bf(r0); Kc[127 * 136 + kvh * 64 + dd + 32] = f2bf(r1); }
    else if (tid < 192) { const int j = tid - 64; const bf16_t vb = qrow[1152 + j]; nv[127 * 128 + j] = bf2f(vb); Vc[127 * 136 + j] = vb; }
    __syncthreads();
#pragma unroll
    for (int r = 0; r < 4; ++r) { const int idx = tid + 512 * r, h = idx >> 7, s = idx & 127, kvh = h >> 3; float dot = 0.f;
#pragma unroll
        for (int c = 0; c < 8; ++c) { const u32x4 kk = *(const LAS u32x4*)(Kc + s * 136 + kvh * 64 + 8 * c); const f32x4 qa = *(const LAS f32x4*)(qs + h * 64 + 8 * c), qb = *(const LAS f32x4*)(qs + h * 64 + 8 * c + 4);
            dot += bflo(kk[0]) * qa[0] + bfhi(kk[0]) * qa[1] + bflo(kk[1]) * qa[2] + bfhi(kk[1]) * qa[3] + bflo(kk[2]) * qb[0] + bfhi(kk[2]) * qb[1] + bflo(kk[3]) * qb[2] + bfhi(kk[3]) * qb[3]; }
        ps[h * 128 + s] = dot; }
    __syncthreads();
#pragma unroll
    for (int x = 0; x < 2; ++x) { const int hh = w + 8 * x; const float sink = F.in[8][hh];
        const float v0 = ps[hh * 128 + lane], v1 = ps[hh * 128 + 64 + lane];
        const float m = fmaxf(wave_max(fmaxf(v0, v1)), sink); const float e0 = __expf(v0 - m), e1 = __expf(v1 - m);
        const float inv = 1.f / (wave_sum(e0 + e1) + __expf(sink - m));
        ps[hh * 128 + lane] = e0 * inv; ps[hh * 128 + 64 + lane] = e1 * inv; }
    __syncthreads();
    { const int h = tid >> 5, dp = tid & 31, kvh = h >> 3; float a0 = 0.f, a1 = 0.f;
#pragma unroll 4
        for (int s4 = 0; s4 < 128; s4 += 4) { const f32x4 p = *(const LAS f32x4*)(ps + h * 128 + s4);
#pragma unroll
            for (int x = 0; x < 4; ++x) { const unsigned vv = *(const LAS unsigned*)(Vc + (s4 + x) * 136 + kvh * 64 + 2 * dp); a0 += p[x] * bflo(vv); a1 += p[x] * bfhi(vv); } }
        *(unsigned*)(F.XN + (size_t)row * DM + h * 64 + 2 * dp) = cvt_pk_bf16(a0, a1); }
    __syncthreads();
}

__device__ __forceinline__ void gla_prompt_unit(const Frame& F, int b, int h, int vs) {
    constexpr int BUFB = 67584;
    LAS float* seg = (LAS float*)(F.lds + 2 * BUFB);
    LAS float* ssl = (LAS float*)(F.lds + 2 * BUFB + 4096);
    const int lane = F.lane, w = F.wave, fr = lane & 15, g = lane >> 4, vt = w & 3, th = w >> 2;
    const bf16_t* P = F.R1; const float* LA = F.LA;
    f32x4 S[8];
#pragma unroll
    for (int i = 0; i < 8; ++i) S[i] = (f32x4){0.f, 0.f, 0.f, 0.f};
    f32x2 rla[2][8]; unsigned rq[2][8], rk[2][8], rv[2][4];
    const int vjp = lane & 31, vtq = (lane >> 5) + 2 * w;
#define GLA_LOAD(c, p) do { const int row0_ = b * SEQ + 64 * (c); _Pragma("unroll") for (int i = 0; i < 8; ++i) { const size_t ro = (size_t)(row0_ + 8 * w + i); \
        rla[p][i] = *(const f32x2*)(LA + ro * 512 + h * 128 + 2 * lane); rq[p][i] = *(const unsigned*)(P + ro * NPROJ + h * 128 + 2 * lane); rk[p][i] = *(const unsigned*)(P + ro * NPROJ + 512 + h * 128 + 2 * lane); } \
        _Pragma("unroll") for (int i = 0; i < 4; ++i) rv[p][i] = *(const unsigned*)(P + (size_t)(row0_ + 4 * vtq + i) * NPROJ + 1024 + h * 256 + vs * 64 + 2 * vjp); } while (0)
#define GLA_SSQ(c) do { if (w == 0) F.SSQ[(size_t)(b * SEQ + 64 * (c) + lane) * 16 + h * 4 + vs] = (ssl[lane] + ssl[64 + lane]) + (ssl[128 + lane] + ssl[192 + lane]); } while (0)
    GLA_LOAD(0, 0); GLA_LOAD(1, 1);
    for (int c2 = 0; c2 < 32; c2 += 2) {
#pragma unroll
    for (int p = 0; p < 2; ++p) {
        const int c = c2 + p;
        const int row0 = b * SEQ + 64 * c;
        LAS unsigned char* bufp = F.lds + (c & 1) * BUFB;
        LAS bf16_t* Qin = (LAS bf16_t*)bufp; LAS bf16_t* Kin = (LAS bf16_t*)(bufp + 17408); LAS bf16_t* KoT = (LAS bf16_t*)(bufp + 34816); LAS bf16_t* Vt = (LAS bf16_t*)(bufp + 53248); LAS float* dec = (LAS float*)(bufp + 66560);
        float c0[8], c1[8]; float run0 = 0.f, run1 = 0.f;
#pragma unroll
        for (int i = 0; i < 8; ++i) { run0 += rla[p][i].x; run1 += rla[p][i].y; c0[i] = run0; c1[i] = run1; }
        *(LAS f32x2*)(seg + w * 128 + 2 * lane) = (f32x2){run0, run1};
        __syncthreads();
        if (c > 0) GLA_SSQ(c - 1);
        float pre0 = 0.f, pre1 = 0.f, tot0 = 0.f, tot1 = 0.f;
#pragma unroll
        for (int x = 0; x < 8; ++x) { const f32x2 sv = *(const LAS f32x2*)(seg + x * 128 + 2 * lane); tot0 += sv.x; tot1 += sv.y; if (x < w) { pre0 += sv.x; pre1 += sv.y; } }
        { const float et0 = __expf(tot0), et1 = __expf(tot1); float ko0[8], ko1[8];
#pragma unroll
            for (int i = 0; i < 8; ++i) { const int t = 8 * w + i; const float e0 = __expf(pre0 + c0[i]), e1 = __expf(pre1 + c1[i]), i0 = __builtin_amdgcn_rcpf(e0), i1 = __builtin_amdgcn_rcpf(e1);
                const float q0 = bflo(rq[p][i]), q1 = bfhi(rq[p][i]), k0 = bflo(rk[p][i]) * i0, k1 = bfhi(rk[p][i]) * i1;
                *(LAS unsigned*)(Qin + t * 136 + 2 * lane) = cvt_pk_bf16(q0 * QS_GLA * e0, q1 * QS_GLA * e1);
                *(LAS unsigned*)(Kin + t * 136 + 2 * lane) = cvt_pk_bf16(k0, k1);
                ko0[i] = k0 * et0; ko1[i] = k1 * et1; }
            *(LAS u32x4*)(KoT + (2 * lane) * 72 + 8 * w) = (u32x4){cvt_pk_bf16(ko0[0], ko0[1]), cvt_pk_bf16(ko0[2], ko0[3]), cvt_pk_bf16(ko0[4], ko0[5]), cvt_pk_bf16(ko0[6], ko0[7])};
            *(LAS u32x4*)(KoT + (2 * lane + 1) * 72 + 8 * w) = (u32x4){cvt_pk_bf16(ko1[0], ko1[1]), cvt_pk_bf16(ko1[2], ko1[3]), cvt_pk_bf16(ko1[4], ko1[5]), cvt_pk_bf16(ko1[6], ko1[7])};
            if (w == 0) *(LAS f32x2*)(dec + 2 * lane) = (f32x2){et0, et1}; }
        { u32x2 lo, hi;
            lo.x = (rv[p][0] & 0xffffu) | (rv[p][1] << 16); lo.y = (rv[p][2] & 0xffffu) | (rv[p][3] << 16); hi.x = (rv[p][0] >> 16) | (rv[p][1] & 0xffff0000u); hi.y = (rv[p][2] >> 16) | (rv[p][3] & 0xffff0000u);
            *(LAS u32x2*)(Vt + (2 * vjp) * 72 + 4 * vtq) = lo; *(LAS u32x2*)(Vt + (2 * vjp + 1) * 72 + 4 * vtq) = hi; }
        __syncthreads();
        if (c < 30) GLA_LOAD(c + 2, p);
#pragma unroll
        for (int ti = 0; ti < 2; ++ti) {
            const int tt = th == 0 ? (ti == 0 ? 0 : 3) : (ti == 0 ? 1 : 2);
            f32x4 o = {0.f, 0.f, 0.f, 0.f};
            const LAS bf16_t* qrow = Qin + (tt * 16 + fr) * 136;
#pragma unroll
            for (int ks = 0; ks < 4; ++ks) {
                const bf16x8 A = mk8(cvt_pk_bf16(S[2 * ks][0], S[2 * ks][1]), cvt_pk_bf16(S[2 * ks][2], S[2 * ks][3]), cvt_pk_bf16(S[2 * ks + 1][0], S[2 * ks + 1][1]), cvt_pk_bf16(S[2 * ks + 1][2], S[2 * ks + 1][3]));
                const u32x2 blo = *(const LAS u32x2*)(qrow + (2 * ks) * 16 + 4 * g), bhi = *(const LAS u32x2*)(qrow + (2 * ks + 1) * 16 + 4 * g);
                o = mfma16(A, mk8(blo.x, blo.y, bhi.x, bhi.y), o);
            }
#pragma unroll
            for (int sp = 0; sp < 2; ++sp) {
                if (2 * sp <= tt) {
                    f32x4 at[2];
#pragma unroll
                    for (int x = 0; x < 2; ++x) { const int st = 2 * sp + x; at[x] = (f32x4){0.f, 0.f, 0.f, 0.f};
                        if (st <= tt) { const LAS bf16_t* kr = Kin + (st * 16 + fr) * 136 + 8 * g;
#pragma unroll
                            for (int ks = 0; ks < 4; ++ks) at[x] = mfma16(*(const LAS bf16x8*)(kr + 32 * ks), *(const LAS bf16x8*)(qrow + 8 * g + 32 * ks), at[x]);
                            if (st == tt) {
#pragma unroll
                                for (int e = 0; e < 4; ++e) if (4 * g + e > fr) at[x][e] = 0.f; } } }
                    const LAS bf16_t* vr = Vt + (vt * 16 + fr) * 72 + 4 * g;
                    const u32x2 alo = *(const LAS u32x2*)(vr + (2 * sp) * 16), ahi = *(const LAS u32x2*)(vr + (2 * sp + 1) * 16);
                    o = mfma16(mk8(alo.x, alo.y, ahi.x, ahi.y), mk8(cvt_pk_bf16(at[0][0], at[0][1]), cvt_pk_bf16(at[0][2], at[0][3]), cvt_pk_bf16(at[1][0], at[1][1]), cvt_pk_bf16(at[1][2], at[1][3])), o);
                }
            }
            const int t = tt * 16 + fr;
            u32x2 wv; wv.x = cvt_pk_bf16(o[0], o[1]); wv.y = cvt_pk_bf16(o[2], o[3]);
            *(u32x2*)(F.OB + (size_t)(row0 + t) * DM + h * 256 + vs * 64 + vt * 16 + 4 * g) = wv;
            float ss = (o[0] * o[0] + o[1] * o[1]) + (o[2] * o[2] + o[3] * o[3]);
            ss += __shfl_xor(ss, 16); ss += __shfl_xor(ss, 32);
            if (g == 0) ssl[vt * 64 + t] = ss;
        }
#pragma unroll
        for (int dt = 0; dt < 8; ++dt) {
            const f32x4 dv = *(const LAS f32x4*)(dec + dt * 16 + 4 * g);
            f32x4 acc = S[dt] * dv;
            const LAS bf16_t* ar = KoT + (dt * 16 + fr) * 72 + 8 * g; const LAS bf16_t* br = Vt + (vt * 16 + fr) * 72 + 8 * g;
            acc = mfma16(*(const LAS bf16x8*)ar, *(const LAS bf16x8*)br, acc); acc = mfma16(*(const LAS bf16x8*)(ar + 32), *(const LAS bf16x8*)(br + 32), acc);
            S[dt] = acc;
        }
    }
    }
    __syncthreads();
    GLA_SSQ(31);
#undef GLA_LOAD
#undef GLA_SSQ
    if (th == 0) {
        float* so = F.out + O_GP + ((size_t)(b * 4 + h) * 128) * 256 + vs * 64 + vt * 16 + fr;
#pragma unroll
        for (int dt = 0; dt < 8; ++dt)
#pragma unroll
            for (int e = 0; e < 4; ++e) so[(size_t)(dt * 16 + 4 * g + e) * 256] = S[dt][e];
    }
    __syncthreads();
}
__device__ __forceinline__ void gla_sample_unit(const Frame& F, int b, int h) {
    LAS float* red = (LAS float*)F.lds;
    LAS float* ssr = red + 2048;
    const int tid = F.tid, lane = F.lane, w = F.wave;
    const int row = SROW + b; const bf16_t* pr = F.R1 + (size_t)row * NPROJ; const float* la = F.LA + (size_t)row * 512 + h * 128;
    const u32x2 vv = *(const u32x2*)(pr + 1024 + h * 256 + 4 * lane); const f32x4 v4 = {bflo(vv.x), bfhi(vv.x), bflo(vv.y), bfhi(vv.y)};
    const float* s0 = F.in[4] + ((size_t)(b * 4 + h) * 128) * 256 + 4 * lane; float* s1 = F.out + O_GS + ((size_t)(b * 4 + h) * 128) * 256 + 4 * lane;
    f32x4 o4 = {0.f, 0.f, 0.f, 0.f};
#pragma unroll 4
    for (int i = 0; i < 16; ++i) { const int d = 16 * w + i; const float a = __expf(la[d]), kd = bf2f(pr[512 + h * 128 + d]), qd = bf2f(pr[h * 128 + d]) * QS_GLA;
        f32x4 s = *(const f32x4*)(s0 + (size_t)d * 256); s = s * a + v4 * kd; *(f32x4*)(s1 + (size_t)d * 256) = s; o4 += s * qd; }
    *(LAS f32x4*)(red + w * 256 + 4 * lane) = o4;
    __syncthreads();
    float o = 0.f, ss = 0.f;
    if (tid < 256) {
#pragma unroll
        for (int x = 0; x < 8; ++x) o += red[x * 256 + tid];
        F.OB[(size_t)row * DM + h * 256 + tid] = f2bf(o); ss = o * o; }
    ss = wave_sum(ss); if (lane == 0) ssr[w] = ss;
    __syncthreads();
    if (tid == 0) *(f32x4*)(F.SSQ + (size_t)row * 16 + h * 4) = (f32x4){(ssr[0] + ssr[1]) + (ssr[2] + ssr[3]), 0.f, 0.f, 0.f};
    __syncthreads();
}
__device__ __forceinline__ void gla_norm_phase(const Frame& F) {
    const int gw = blockIdx.x * 8 + F.wave, NGW = F.G * 8, lane = F.lane, hh = lane >> 4;
    f32x4 ng[4];
#pragma unroll
    for (int j = 0; j < 4; ++j) ng[j] = *(const f32x4*)(F.in[14] + (lane & 15) * 16 + 4 * j);
    for (int i = 2 * gw; i < MP + NS; i += 2 * NGW) {
        u32x4 ov[2][2], gv[2][2]; f32x4 sq[2]; bf16_t* op[2];
#pragma unroll
        for (int q = 0; q < 2; ++q) { const int ii = i + q, r = ii < MP ? ii : SROW + (ii - MP);
            sq[q] = *(const f32x4*)(F.SSQ + (size_t)r * 16 + hh * 4);
            op[q] = F.OB + (size_t)r * DM + lane * 16; const bf16_t* gp = F.R1 + (size_t)r * NPROJ + 2048 + lane * 16;
            ov[q][0] = *(const u32x4*)op[q]; ov[q][1] = *(const u32x4*)(op[q] + 8); gv[q][0] = *(const u32x4*)gp; gv[q][1] = *(const u32x4*)(gp + 8); }
#pragma unroll
        for (int q = 0; q < 2; ++q) { const float rs = 1.f / sqrtf(((sq[q][0] + sq[q][1]) + (sq[q][2] + sq[q][3])) * (1.f / 256.f) + 1e-6f);
#pragma unroll
            for (int x = 0; x < 2; ++x) { u32x4 w;
#pragma unroll
                for (int e = 0; e < 4; ++e) { const float o0 = bflo(ov[q][x][e]), o1 = bfhi(ov[q][x][e]), g0 = bflo(gv[q][x][e]), g1 = bfhi(gv[q][x][e]);
                    const int k = 8 * x + 2 * e; const float n0 = ng[k >> 2][k & 3], n1 = ng[(k + 1) >> 2][(k + 1) & 3];
                    w[e] = cvt_pk_bf16(o0 * rs * n0 * (g0 / (1.f + __expf(-g0))), o1 * rs * n1 * (g1 / (1.f + __expf(-g1)))); }
                *(u32x4*)(op[q] + 8 * x) = w; } }
    }
}

template <class EpiS>
__device__ __forceinline__ void sample_gemm(const Frame& F, const bf16_t* A, const bf16_t* Bt, int N, int K, const EpiS& E) {
    LAS float* red = (LAS float*)F.lds;
    const int lane = F.lane, w = F.wave, fr = lane & 15, g = lane >> 4, kw = K >> 3, npieces = (N >> 5) * 8;
    for (int p = blockIdx.x; p < npieces; p += F.G) {
        const int rg = p & 7, cgp = p >> 3;
        const bf16_t* ap = A + (size_t)(rg * 16 + fr) * K + w * kw + 8 * g;
        const bf16_t* b0 = Bt + (size_t)(cgp * 32 + fr) * K + w * kw + 8 * g; const bf16_t* b1 = b0 + (size_t)16 * K;
        f32x4 c0 = {0.f, 0.f, 0.f, 0.f}, c1 = {0.f, 0.f, 0.f, 0.f};
#pragma unroll 4
        for (int k = 0; k < kw; k += 32) { const bf16x8 a = *(const bf16x8*)(ap + k), x0 = *(const bf16x8*)(b0 + k), x1 = *(const bf16x8*)(b1 + k);
            c0 = mfma16(x0, a, c0); c1 = mfma16(x1, a, c1); }
        *(LAS f32x4*)(red + w * 512 + fr * 32 + 4 * g) = c0; *(LAS f32x4*)(red + w * 512 + fr * 32 + 16 + 4 * g) = c1;
        __syncthreads();
        { float v = 0.f;
#pragma unroll
            for (int x = 0; x < 8; ++x) v += red[x * 512 + F.tid];
            E(rg * 16 + (F.tid >> 5), cgp * 32 + (F.tid & 31), v); }
        __syncthreads();
    }
}
struct SEpiRes { const float* res; const bf16_t* resB; bf16_t* out;
    __device__ __forceinline__ void operator()(int b, int col, float v) const { const float x = res ? res[(size_t)b * DM + col] : bf2f(resB[(size_t)b * DM + col]); out[(size_t)b * DM + col] = f2bf(ALPHA * x + v); } };
struct SEpiGlaIn { bf16_t* P; float* LA; const float* ba;
    __device__ __forceinline__ void operator()(int b, int col, float v) const {
        if (col < NPROJ) P[(size_t)(SROW + b) * NPROJ + col] = f2bf(v);
        else { const float z = v + ba[col - NPROJ]; LA[(size_t)(SROW + b) * 512 + col - NPROJ] = -(fmaxf(-z, 0.f) + log1pf(__expf(-fabsf(z)))) * 0.0625f; } } };

struct Args { const float* in[24]; float* out; unsigned char* ws; int ph_lo, ph_hi; };
constexpr int NPHASE = 16;
__global__ void __launch_bounds__(512, 2) mega_fwd(Args args) {
    extern __shared__ __attribute__((aligned(16))) unsigned char lds[];
    cg::grid_group grid = cg::this_grid();
    Frame F;
    F.lds = (LAS unsigned char*)lds;
    F.tid = threadIdx.x; F.lane = F.tid & 63; F.wave = __builtin_amdgcn_readfirstlane(F.tid >> 6); F.G = gridDim.x;
#pragma unroll
    for (int i = 0; i < 24; ++i) F.in[i] = args.in[i];
    F.out = args.out;
    unsigned char* ws = args.ws;
    F.Wqkv = (bf16_t*)(ws + WS_WQKV); F.Wo = (bf16_t*)(ws + WS_WO); F.Wup = (bf16_t*)(ws + WS_WUP); F.Wdn = (bf16_t*)(ws + WS_WDN); F.Wgin = (bf16_t*)(ws + WS_WGIN); F.Wgo = (bf16_t*)(ws + WS_WGO);
    F.XN = (bf16_t*)(ws + WS_XN) + 8 * DM; F.OB = (bf16_t*)(ws + 400 * MiB); F.YB = (bf16_t*)(ws + WS_LA);     F.R1 = (bf16_t*)(ws + WS_R1); F.LA = (float*)(ws + WS_LA); F.SSQ = (float*)(ws + WS_SSQ);
    F.ropec = (float*)(ws + WS_ROPE); F.ropes = F.ropec + 2049 * 32;
    volatile LAS unsigned* MISC = (volatile LAS unsigned*)(F.lds + LDS_BYTES - 64);
    if (F.tid < 4) MISC[F.tid] = 0u;
    __syncthreads();
    XcdBarrier xbar = xcd_barrier_post((unsigned*)(ws + 16384), MISC);
    const int lo = args.ph_lo, hi = args.ph_hi;
#ifndef PH_MASK
#define PH_MASK 0xffff
#endif
#define IN(k) (((PH_MASK >> (k)) & 1) && lo <= (k) && (k) < hi)
#define GRID_SEAM_CG() do { asm volatile("s_waitcnt vmcnt(0) lgkmcnt(0)" ::: "memory"); grid.sync(); \
        if (F.tid == 0) { __builtin_amdgcn_fence(__ATOMIC_ACQUIRE, "agent"); asm volatile("s_waitcnt vmcnt(0)" ::: "memory"); } __syncthreads(); } while (0)
#define GRID_SEAM() do { xcd_barrier(xbar); } while (0)
#ifndef PROBE_SPIN
#define PROBE_SPIN 0
#endif
#ifndef PROBE_RVR
#define PROBE_RVR 0
#endif
#ifndef PROBE_CAL
#define PROBE_CAL 0
#endif
#define PROBING (PROBE_SPIN || PROBE_RVR || PROBE_CAL)
    unsigned long long* const tsb = (unsigned long long*)(ws + 4096);
#define STAMP(k) do { if (PROBING && blockIdx.x == 0 && F.tid == 0) tsb[k] = __builtin_amdgcn_s_memrealtime(); } while (0)
#define SEAM(k) do { if (IN(k) && IN((k) + 1)) { if ((k) == 0) GRID_SEAM_CG(); else GRID_SEAM(); STAMP((k) + 1); } } while (0)
    STAMP(0);
    using pg8::Gemm; using pg8::StaticOrder;

    if (IN(0)) { p0_prologue(F); } SEAM(0);
    if (IN(1)) {
        Gemm g{F.XN, F.Wqkv, NQKV, DM, 129, 0}; StaticOrder S; S.init(129, NQKV, F.G, (int)blockIdx.x);
        pg8::EpiBf16Bias E{F.R1, NQKV, F.in[7]};
        pg8::gemm_phase<pg8::EpiBf16Bias, StaticOrder, true, true>(F.lds, g, S, E);
    } SEAM(1);
    if (IN(2)) {
        for (int u = blockIdx.x; u < 640; u += F.G) {
            if (u < 128) attn_sample_unit(F, u);
            else { const int v = u - 128; attn_prompt_unit(F, v >> 5, (v >> 4) & 1, v & 15); }
        }
    } SEAM(2);
    if (IN(3)) {
        { SEpiRes ES{F.in[1], nullptr, F.YB + (size_t)SROW * DM}; sample_gemm(F, F.XN + (size_t)SROW * DM, F.Wo, DM, DM, ES); }
        Gemm g{F.XN, F.Wo, DM, DM, 128, 0}; StaticOrder S; S.init(128, DM, F.G, (int)blockIdx.x);
        pg8::EpiRes<false> E{F.in[0], F.in[1], nullptr, F.YB};
#ifdef DBG_COPY
        (void)g; (void)S; (void)E;
        for (int idx = blockIdx.x * 512 + F.tid; idx < (MP + NS) * 128; idx += F.G * 512) { const int i = idx >> 7, c = (idx & 127) * 8; const int r = i < MP ? i : SROW + (i - MP);
            const u32x4 v = *(const u32x4*)(F.OB + (size_t)r * DM + c); float* o = F.out + (size_t)i * DM + c;
            *(f32x4*)o = (f32x4){bflo(v[0]), bfhi(v[0]), bflo(v[1]), bfhi(v[1])}; *(f32x4*)(o + 4) = (f32x4){bflo(v[2]), bfhi(v[2]), bflo(v[3]), bfhi(v[3])}; }
#else
        pg8::gemm_phase<pg8::EpiRes<false>, StaticOrder, true, true>(F.lds, g, S, E);
#endif
    } SEAM(3);
    if (IN(4)) { ln_phase(F, F.in[20], F.in[21], false); } SEAM(4);
#define FFN_PHASES(l, pb) do { \
        if (IN(pb)) { \
            Gemm g{F.XN, F.Wup + (size_t)(l) * NUP * DM, NUP, DM, 134, 1}; StaticOrder S; S.init(134, NUP, F.G, (int)blockIdx.x); \
            pg8::EpiUp E{F.R1, F.in[17] + (size_t)(l) * 3 * FF, F.in[18] + (size_t)(l) * FF, F.in[5] + (size_t)(l) * NS * 2 * FF, F.out + O_CP + (size_t)(l) * NBATCH * 2 * FF, F.out + O_CS + (size_t)(l) * NS * 2 * FF}; \
            pg8::gemm_phase<pg8::EpiUp, StaticOrder, true, true>(F.lds, g, S, E); \
        } SEAM(pb); \
        if (IN((pb) + 1)) { \
            { SEpiRes ES{nullptr, F.XN + (size_t)SROW * DM, F.YB + (size_t)SROW * DM}; sample_gemm(F, F.R1 + (size_t)SROW * FF, F.Wdn + (size_t)(l) * DM * FF, DM, FF, ES); } \
            Gemm g{F.R1, F.Wdn + (size_t)(l) * DM * FF, DM, FF, 128, 0}; StaticOrder S; S.init(128, DM, F.G, (int)blockIdx.x); \
            pg8::EpiRes<true> E{nullptr, nullptr, F.XN, F.YB}; \
            pg8::gemm_phase<pg8::EpiRes<true>, StaticOrder, true, true>(F.lds, g, S, E); \
        } SEAM((pb) + 1); \
        if (IN((pb) + 2)) { ln_phase(F, F.in[22] + (size_t)(l) * DM, F.in[23] + (size_t)(l) * DM, (l) == 1); } SEAM((pb) + 2); } while (0)
    FFN_PHASES(0, 5);
    if (IN(8)) {
        { SEpiGlaIn ES{F.R1, F.LA, F.in[13]}; sample_gemm(F, F.XN + (size_t)SROW * DM, F.Wgin, NGIN, DM, ES); }
        Gemm g{F.XN, F.Wgin, NGIN, DM, 128, 0}; StaticOrder S; S.init(128, NGIN, F.G, (int)blockIdx.x);
        pg8::EpiGlaIn E{F.R1, F.LA, F.in[13]};
        pg8::gemm_phase<pg8::EpiGlaIn, StaticOrder, true, true>(F.lds, g, S, E);
    } SEAM(8);
    if (IN(9)) {
        for (int u = blockIdx.x; u < 768; u += F.G) {
            if (u < 256) gla_prompt_unit(F, u >> 4, (u >> 2) & 3, u & 3);
            else { const int v = u - 256; gla_sample_unit(F, v >> 2, v & 3); }
        }
    } SEAM(9);
    if (IN(10)) { gla_norm_phase(F); } SEAM(10);
    if (IN(11)) {
        { SEpiRes ES{nullptr, F.XN + (size_t)SROW * DM, F.YB + (size_t)SROW * DM}; sample_gemm(F, F.OB + (size_t)SROW * DM, F.Wgo, DM, DM, ES); }
        Gemm g{F.OB, F.Wgo, DM, DM, 128, 0}; StaticOrder S; S.init(128, DM, F.G, (int)blockIdx.x);
        pg8::EpiRes<true> E{nullptr, nullptr, F.XN, F.YB};
        pg8::gemm_phase<pg8::EpiRes<true>, StaticOrder, true, true>(F.lds, g, S, E);
    } SEAM(11);
    if (IN(12)) { ln_phase(F, F.in[20] + DM, F.in[21] + DM, false); } SEAM(12);
    FFN_PHASES(1, 13);
#undef FFN_PHASES
    if (PROBING) {
        GRID_SEAM(); STAMP(16);
        if (blockIdx.x == 0 && F.tid == 0) {
            unsigned long long spin = 0, rv = 0;
            for (int k = 0; k < 16; ++k) { const unsigned long long d = tsb[k + 1] - tsb[k]; if ((PROBE_SPIN >> k) & 1) spin += d; if ((PROBE_RVR >> k) & 1) rv += d; }
            tsb[32] = spin; ((float*)(tsb + 33))[0] = 0.01f * sqrtf(1.f + (float)rv * 0.01f / 4000.f);
        }
        GRID_SEAM();
        const unsigned long long spin = tsb[32]; const float dd = 1.f + ((const float*)(tsb + 33))[0];
        for (int idx = blockIdx.x * 512 + F.tid; idx < 1441792 / 4; idx += F.G * 512) { f32x4* p = (f32x4*)(F.out + O_CS) + idx; *p = *p * dd; }
        const unsigned long long t0 = __builtin_amdgcn_s_memrealtime();
        while (__builtin_amdgcn_s_memrealtime() - t0 < spin) __builtin_amdgcn_s_sleep(8);
    }
#undef IN
#undef SEAM
}

extern "C" void kernel_launch(void* const* d_in, const int* in_sizes, int n_in, void* d_out, int out_size, void* d_ws, size_t ws_size, hipStream_t stream) {
    static int grid = 0;
    if (grid == 0) {
        if (n_in != 24 || out_size != 58900480 || ws_size < 466 * MiB) { fprintf(stderr, "kernel_launch: unexpected shapes (n_in %d out %d ws %zu)\n", n_in, out_size, ws_size); grid = -1; return; }
        int dev = 0, cus = 0, per_cu = 0;
        if (hipGetDevice(&dev) != hipSuccess || hipDeviceGetAttribute(&cus, hipDeviceAttributeMultiprocessorCount, dev) != hipSuccess) { grid = -1; return; }
        if (hipFuncSetAttribute((const void*)mega_fwd, hipFuncAttributeMaxDynamicSharedMemorySize, LDS_BYTES) != hipSuccess) { fprintf(stderr, "kernel_launch: hipFuncSetAttribute failed\n"); grid = -1; return; }
        if (hipOccupancyMaxActiveBlocksPerMultiprocessor(&per_cu, (const void*)mega_fwd, 512, LDS_BYTES) != hipSuccess || per_cu < 1) { fprintf(stderr, "kernel_launch: occupancy query says %d\n", per_cu); per_cu = 1; }
        (void)hipGetLastError();
        grid = cus * 1;
    }
    if (grid < 0) return;
    if (hipMemsetAsync((char*)d_ws + 16384, 0, 16384, stream) != hipSuccess) { fprintf(stderr, "kernel_launch: memset failed\n"); return; }
    Args a{};
    for (int i = 0; i < 24; ++i) a.in[i] = (const float*)d_in[i];
    a.out = (float*)d_out; a.ws = (unsigned char*)d_ws;
#if MK_PER_PHASE
    for (int p = 0; p < NPHASE; ++p) { a.ph_lo = p; a.ph_hi = p + 1; hipLaunchKernelGGL(mega_fwd, dim3(grid), dim3(512), LDS_BYTES, stream, a); }
#else
    a.ph_lo = 0; a.ph_hi = NPHASE;
    void* kargs[] = {&a};
    const hipError_t e = hipLaunchCooperativeKernel((const void*)mega_fwd, dim3(grid), dim3(512), kargs, LDS_BYTES, stream);
    if (e != hipSuccess) fprintf(stderr, "kernel_launch: cooperative launch failed: %s (grid %d)\n", hipGetErrorString(e), grid);
#endif
}
```

```cpp
#include <hip/hip_runtime.h>
#include <hip/hip_cooperative_groups.h>
#include <cstdio>
#include <cstdint>
namespace cg = cooperative_groups;

#ifndef MK_PER_PHASE
#define MK_PER_PHASE 0
#endif

constexpr int DM = 1024, NBATCH = 16, SEQ = 2048, MP = NBATCH * SEQ, NS = 128;
constexpr int SROW = 33024;
constexpr int MROWS = 33280;
constexpr int NQKV = 1280, FF = 2816, NUP = 2 * FF, NPROJ = 3072, NGIN = 3584;
constexpr float ALPHA = 1.41421356237f, LN_EPS = 1e-5f, QS_GLA = 0.08838834764831845f;
constexpr size_t O_Y = 0, O_YS = 33554432, O_KP = 33685504, O_VP = 33947648, O_KS = 34209792, O_VS = 36306944, O_GP = 38404096, O_GS = 40501248, O_CP = 57278464, O_CS = 57458688;
constexpr size_t MiB = 1u << 20;
constexpr size_t WS_ROPE = 1 * MiB;
constexpr size_t WS_WQKV = 2 * MiB;
constexpr size_t WS_WO = WS_WQKV + 2621440;
constexpr size_t WS_WUP = WS_WO + 2 * MiB;
constexpr size_t WS_WDN = WS_WUP + 22 * MiB;
constexpr size_t WS_WGIN = WS_WDN + 11 * MiB;
constexpr size_t WS_WGO = WS_WGIN + 7 * MiB;
constexpr size_t WS_XN = 50 * MiB;
constexpr size_t WS_SSQ = 116 * MiB;
constexpr size_t WS_R1 = 119 * MiB;
constexpr size_t WS_LA = WS_R1 + (size_t)MROWS * NPROJ * 2;
constexpr size_t WS_END = WS_LA + (size_t)MROWS * 512 * 4;
static_assert(WS_WGO + 2 * MiB <= WS_XN && WS_XN + (size_t)(MROWS + 8) * DM * 2 <= WS_SSQ && WS_SSQ + (size_t)MROWS * 64 <= WS_R1 && WS_END <= 512 * MiB, "ws map");

constexpr int LDS_BYTES = 147456;

#define LAS __attribute__((address_space(3)))
typedef unsigned short bf16_t;
typedef short bf16x8 __attribute__((ext_vector_type(8)));
typedef float f32x4 __attribute__((ext_vector_type(4)));
typedef float f32x2 __attribute__((ext_vector_type(2)));
typedef unsigned u32x4 __attribute__((ext_vector_type(4)));
typedef unsigned u32x2 __attribute__((ext_vector_type(2)));

typedef __bf16 bf16x2_t __attribute__((ext_vector_type(2)));
__device__ __forceinline__ unsigned cvt_pk_bf16(float lo, float hi) { const f32x2 v = {lo, hi}; return __builtin_bit_cast(unsigned, __builtin_convertvector(v, bf16x2_t)); }
__device__ __forceinline__ float bflo(unsigned w) { return __uint_as_float(w << 16); }
__device__ __forceinline__ float bfhi(unsigned w) { return __uint_as_float(w & 0xffff0000u); }
__device__ __forceinline__ float bf2f(bf16_t h) { return __uint_as_float((unsigned)h << 16); }
__device__ __forceinline__ bf16_t f2bf(float f) { return (bf16_t)(cvt_pk_bf16(f, 0.f) & 0xffffu); }
__device__ __forceinline__ bf16x8 mk8(unsigned a, unsigned b, unsigned c, unsigned d) { u32x4 v = {a, b, c, d}; return __builtin_bit_cast(bf16x8, v); }
__device__ __forceinline__ f32x4 mfma16(bf16x8 a, bf16x8 b, f32x4 c) { return __builtin_amdgcn_mfma_f32_16x16x32_bf16(a, b, c, 0, 0, 0); }
__device__ __forceinline__ bool row_valid(int r) { return r < MP || (r >= SROW && r < SROW + NS); }
__device__ __forceinline__ size_t xy_off(int r) { return (size_t)(r < MP ? r : r - (SROW - MP)) * DM; }

namespace pg8 {
#define PG8_LAS __attribute__((address_space(3)))
constexpr int BM = 256, BK = 64, HALF = 128, HTB = HALF * BK * 2, STAGE_BYTES = 8 * HTB, NXCD = 8, WGM = 8;
__host__ __device__ __forceinline__ int lds_byte(int r, int c) { const int st = (r >> 4) * 2 + (c >> 5), rr = r & 15, cc = c & 31, ob = rr * 64 + cc * 2; return st * 1024 + (ob ^ (((ob >> 9) & 1) << 5)); }
__host__ __device__ __forceinline__ void stage_rc(int b, int& R, int& C) { const int st = b / 1024, sb = b % 1024, swz = sb ^ (((sb >> 9) & 1) << 5); R = (st >> 1) * 16 + swz / 64; C = (st & 1) * 32 + (swz % 64) / 2; }
__host__ __device__ __forceinline__ int perm32(int rho) { const int n = rho >> 4, i = rho & 15; return 8 * (i >> 2) + 4 * n + (i & 3); }

struct Unit { int pm, pn; };
struct Gemm { const bf16_t* A; const bf16_t* Bt; int N, K, nM, mode; };
__device__ __forceinline__ int tile_row0(int pm) { return 256 * (pm < 128 ? pm : 129); }
__device__ __forceinline__ int tile_base1(int pm) { return pm < 133 ? 248 * pm : SROW; }
__device__ __forceinline__ const char* abase(const Gemm& g, int pm) {
    const long row = g.mode ? (long)tile_base1(pm) - 2 : (long)tile_row0(pm);
    return (const char*)g.A + row * (long)g.K * 2;
}

struct StaticOrder {
    int nM, nN, nwg, G, c;
    __host__ __device__ void init(int nM_, int N, int G_, int c_) { nM = nM_; nN = N / BM; nwg = nM * nN; G = G_; c = c_; }
    __host__ __device__ bool next(int i, Unit& u) const {
        const long L = (long)i * G + c; if (L >= nwg) return false;
        int wgid = (int)L; { const int q = nwg / NXCD, r = nwg % NXCD, xcd = wgid % NXCD, off = wgid / NXCD; wgid = (xcd < r ? xcd * (q + 1) : r * (q + 1) + (xcd - r) * q) + off; }
        const int nig = WGM * nN, gid = wgid / nig, fm = gid * WGM, gsz = (nM - fm) < WGM ? (nM - fm) : WGM;
        u.pm = fm + ((wgid % nig) % gsz); u.pn = (wgid % nig) / gsz; return true;
    }
    __device__ __forceinline__ void a_ready(const Unit&) const {}
    __device__ __forceinline__ void done(const Unit&) const {}
};

__device__ __forceinline__ f32x2 gelu_pk(f32x2 v) {
    const f32x2 av = __builtin_elementwise_abs(v), d = av * 0.2316418882f + 1.0f;
    f32x2 t; t.x = __builtin_amdgcn_rcpf(d.x); t.y = __builtin_amdgcn_rcpf(d.y);
    f32x2 q = t * 0.5307027145f + (-0.7265760135f); q = q * t + 0.7107068705f; q = q * t + (-0.142248368f); q = q * t + 0.127414796f; q = q * t;
    const f32x2 s = (v * v) * (-0.72134752044f);
    f32x2 e; e.x = __builtin_amdgcn_exp2f(s.x); e.y = __builtin_amdgcn_exp2f(s.y);
    const f32x2 m = v * (q * e), r = v - m;
    f32x2 o; o.x = v.x < 0.f ? m.x : r.x; o.y = v.y < 0.f ? m.y : r.y; return o;
}

struct EpiBf16Bias {
    static constexpr bool PERM = true, AFTER_DRAIN = false;
    bf16_t* O; int ldc; const float* bias;
    __device__ __forceinline__ void operator()(const f32x4 (&acc)[2][2][4][2], const Unit& u, int wr, int wc, int fr, int fq) const {
        const int row0 = tile_row0(u.pm) + wr * 64 + fr, col0 = u.pn * BM + wc * 32 + 8 * fq;
        f32x4 bv[2][2];
#pragma unroll
        for (int bj = 0; bj < 2; ++bj)
#pragma unroll
            for (int n = 0; n < 2; ++n) bv[bj][n] = *(const f32x4*)(bias + col0 + bj * HALF + 4 * n);
#pragma unroll
        for (int ai = 0; ai < 2; ++ai)
#pragma unroll
            for (int m = 0; m < 4; ++m) { bf16_t* rowp = O + (size_t)(row0 + ai * HALF + m * 16) * ldc + col0;
#pragma unroll
                for (int bj = 0; bj < 2; ++bj) { const f32x4 v0 = acc[ai][bj][m][0] + bv[bj][0], v1 = acc[ai][bj][m][1] + bv[bj][1];
                    u32x4 w; w.x = cvt_pk_bf16(v0[0], v0[1]); w.y = cvt_pk_bf16(v0[2], v0[3]); w.z = cvt_pk_bf16(v1[0], v1[1]); w.w = cvt_pk_bf16(v1[2], v1[3]);
                    *(u32x4*)(rowp + bj * HALF) = w; } }
    }
};
template <bool RESBF> struct EpiRes {
    static constexpr bool PERM = true, AFTER_DRAIN = false;
    const float* resP; const float* resS; const bf16_t* resB; bf16_t* out;
    __device__ __forceinline__ void operator()(const f32x4 (&acc)[2][2][4][2], const Unit& u, int wr, int wc, int fr, int fq) const {
        const int rb = tile_row0(u.pm) + wr * 64 + fr, col0 = u.pn * BM + wc * 32 + 8 * fq;
#pragma unroll
        for (int ai = 0; ai < 2; ++ai)
#pragma unroll
            for (int m = 0; m < 4; ++m) { const int r = rb + ai * HALF + m * 16;
                if (row_valid(r)) {
                    bf16_t* op = out + (size_t)r * DM + col0;
#pragma unroll
                    for (int bj = 0; bj < 2; ++bj) { f32x4 x0, x1;
                        if (RESBF) { const u32x4 rv = *(const u32x4*)(resB + (size_t)r * DM + col0 + bj * HALF);
                            x0 = (f32x4){bflo(rv[0]), bfhi(rv[0]), bflo(rv[1]), bfhi(rv[1])}; x1 = (f32x4){bflo(rv[2]), bfhi(rv[2]), bflo(rv[3]), bfhi(rv[3])}; }
                        else { const float* rp = (r < MP ? resP + (size_t)r * DM : resS + (size_t)(r - SROW) * DM) + col0 + bj * HALF; x0 = *(const f32x4*)rp; x1 = *(const f32x4*)(rp + 4); }
                        const f32x4 y0 = x0 * ALPHA + acc[ai][bj][m][0], y1 = x1 * ALPHA + acc[ai][bj][m][1];
                        *(u32x4*)(op + bj * HALF) = (u32x4){cvt_pk_bf16(y0[0], y0[1]), cvt_pk_bf16(y0[2], y0[3]), cvt_pk_bf16(y1[0], y1[1]), cvt_pk_bf16(y1[2], y1[3])}; } } }
    }
};
struct EpiGlaIn {
    static constexpr bool PERM = true, AFTER_DRAIN = false;
    bf16_t* P; float* LA; const float* ba;
    __device__ __forceinline__ void operator()(const f32x4 (&acc)[2][2][4][2], const Unit& u, int wr, int wc, int fr, int fq) const {
        const int row0 = tile_row0(u.pm) + wr * 64 + fr;
        if (u.pn < 12) {
            const int col0 = u.pn * BM + wc * 32 + 8 * fq;
#pragma unroll
            for (int ai = 0; ai < 2; ++ai)
#pragma unroll
                for (int m = 0; m < 4; ++m) { bf16_t* rowp = P + (size_t)(row0 + ai * HALF + m * 16) * NPROJ + col0;
#pragma unroll
                    for (int bj = 0; bj < 2; ++bj) { const f32x4 v0 = acc[ai][bj][m][0], v1 = acc[ai][bj][m][1];
                        u32x4 w; w.x = cvt_pk_bf16(v0[0], v0[1]); w.y = cvt_pk_bf16(v0[2], v0[3]); w.z = cvt_pk_bf16(v1[0], v1[1]); w.w = cvt_pk_bf16(v1[2], v1[3]);
                        *(u32x4*)(rowp + bj * HALF) = w; } }
        } else {
            const int col0 = (u.pn - 12) * BM + wc * 32 + 8 * fq;
#pragma unroll
            for (int bj = 0; bj < 2; ++bj)
#pragma unroll
                for (int n = 0; n < 2; ++n) { const f32x4 bv = *(const f32x4*)(ba + col0 + bj * HALF + 4 * n);
#pragma unroll
                    for (int ai = 0; ai < 2; ++ai)
#pragma unroll
                        for (int m = 0; m < 4; ++m) { const f32x4 z = acc[ai][bj][m][n] + bv; f32x4 o;
#pragma unroll
                            for (int e = 0; e < 4; ++e) o[e] = -(fmaxf(-z[e], 0.f) + __logf(1.f + __expf(-fabsf(z[e])))) * 0.0625f;
                            *(f32x4*)(LA + (size_t)(row0 + ai * HALF + m * 16) * 512 + col0 + bj * HALF + 4 * n) = o; } }
        }
    }
};
__device__ __forceinline__ float dpp_ror1(float v) { return __int_as_float(__builtin_amdgcn_update_dpp(0, __float_as_int(v), 0x121, 0xf, 0xf, false)); }
__device__ __forceinline__ float dpp_ror2(float v) { return __int_as_float(__builtin_amdgcn_update_dpp(0, __float_as_int(v), 0x122, 0xf, 0xf, false)); }
struct EpiUp {
    static constexpr bool PERM = true, AFTER_DRAIN = false;
    bf16_t* G; const float* cw; const float* cb; const float* sconv; float* ocp; float* ocs;
    __device__ __forceinline__ void operator()(const f32x4 (&acc)[2][2][4][2], const Unit& u, int wr, int wc, int fr, int fq) const {
        const int B = tile_base1(u.pm); const bool samp = (u.pm >= 133);
#pragma unroll
        for (int n = 0; n < 2; ++n) {
            const int f = u.pn * HALF + wc * 32 + 8 * fq + 4 * n;
            const f32x4 w0 = *(const f32x4*)(cw + f), w1 = *(const f32x4*)(cw + FF + f), w2 = *(const f32x4*)(cw + 2 * FF + f), bb = *(const f32x4*)(cb + f);
#pragma unroll
            for (int ai = 0; ai < 2; ++ai) {
                const int seg = 2 * ai + wr;
                f32x4 p1 = {0.f, 0.f, 0.f, 0.f}, p2 = {0.f, 0.f, 0.f, 0.f};
#pragma unroll
                for (int m = 0; m < 4; ++m) {
                    const f32x4 a = acc[ai][0][m][n], uu = acc[ai][1][m][n];
                    f32x4 a1, a2;
#pragma unroll
                    for (int e = 0; e < 4; ++e) { a1[e] = dpp_ror1(a[e]); a2[e] = dpp_ror2(a[e]); }
                    f32x4 s1, s2;
#pragma unroll
                    for (int e = 0; e < 4; ++e) { s1[e] = fr >= 1 ? a1[e] : p1[e]; s2[e] = fr >= 2 ? a2[e] : p2[e]; }
                    p1 = a1; p2 = a2;
                    const int j = 16 * m + fr, r = B + 62 * seg + j - 2;
                    bool doit;
                    if (!samp) {
                        doit = (j >= 2) && (r < MP);
                        const int tt = r & (SEQ - 1);
                        if (tt < 1) s1 = (f32x4){0.f, 0.f, 0.f, 0.f};
                        if (tt < 2) s2 = (f32x4){0.f, 0.f, 0.f, 0.f};
                        if (doit && tt >= SEQ - 2) *(f32x4*)(ocp + ((size_t)(r >> 11) * 2 + (tt - (SEQ - 2))) * FF + f) = a;
                    } else {
                        doit = (j >= 2) && (r < SROW + NS);
                        if (doit) { const int bs = r - SROW;
                            s2 = *(const f32x4*)(sconv + ((size_t)bs * 2 + 0) * FF + f); s1 = *(const f32x4*)(sconv + ((size_t)bs * 2 + 1) * FF + f);
                            *(f32x4*)(ocs + ((size_t)bs * 2 + 0) * FF + f) = s1; *(f32x4*)(ocs + ((size_t)bs * 2 + 1) * FF + f) = a; }
                    }
                    if (doit) {
                        const f32x4 c = bb + w0 * s2 + w1 * s1 + w2 * a;
                        const f32x2 g0 = gelu_pk((f32x2){c[0], c[1]}), g1 = gelu_pk((f32x2){c[2], c[3]});
                        u32x2 w; w.x = cvt_pk_bf16(g0.x * uu[0], g0.y * uu[1]); w.y = cvt_pk_bf16(g1.x * uu[2], g1.y * uu[3]);
                        *(u32x2*)(G + (size_t)r * FF + f) = w;
                    }
                }
            }
        }
    }
};

template <class Epi, class Sched, bool ALIGN_EPI = false, bool SP2 = false>
__device__ __forceinline__ void gemm_phase(PG8_LAS unsigned char* lds, const Gemm g, const Sched& S, const Epi& E) {
    const int tid = threadIdx.x, wid = __builtin_amdgcn_readfirstlane(tid >> 6), lane = tid & 63, wr = wid >> 2, wc = wid & 3, fr = lane & 15, fq = lane >> 4;
    const int K = g.K, nt = K / BK;
    unsigned voffA[2], voffB[2];
#pragma unroll
    for (int i = 0; i < 2; ++i) { int R, C; stage_rc(tid * 16 + i * 8192, R, C); const int Rb = Epi::PERM ? ((R & ~31) + perm32(R & 31)) : R;
        voffA[i] = (unsigned)((g.mode ? (R - 2 * (R >> 6)) : R) * K + C) * 2u; voffB[i] = (unsigned)(Rb * K + C) * 2u; }
    const size_t kstep = (size_t)(BK * 2);
    const size_t hstep = (size_t)HALF * K * 2;
    const size_t tstep = 2 * hstep; const size_t hsA = g.mode ? (size_t)124 * K * 2 : hstep;
    const unsigned ldsw = (unsigned)wid * 1024u;
    const int aoff = lds_byte(wr * 64 + fr, fq * 8), boff = lds_byte(wc * 32 + fr, fq * 8);
#define PG8_SA(b, h) (((b) * 2 + (h)) * HTB)
#define PG8_SB(b, h) ((4 + (b) * 2 + (h)) * HTB)
#define PG8_STAGE(bufoff, gbase, voff) do { _Pragma("unroll") for (int _i = 0; _i < 2; ++_i) \
        __builtin_amdgcn_global_load_lds((const unsigned*)((const char*)(gbase) + (voff)[_i]), (PG8_LAS unsigned*)(lds + (bufoff) + ldsw + _i * 8192), 16, 0, 0); } while (0)
#define PG8_LDA(dst, b, h) do { _Pragma("unroll") for (int m = 0; m < 4; ++m) _Pragma("unroll") for (int k = 0; k < 2; ++k) dst[m][k] = *(const PG8_LAS bf16x8*)(lds + PG8_SA(b, h) + aoff + m * 2048 + k * 1024); } while (0)
#define PG8_LDB(dst, b, h) do { _Pragma("unroll") for (int n = 0; n < 2; ++n) _Pragma("unroll") for (int k = 0; k < 2; ++k) dst[n][k] = *(const PG8_LAS bf16x8*)(lds + PG8_SB(b, h) + boff + n * 2048 + k * 1024); } while (0)
#define PG8_MMA(ai, bj, At, Bt) do { __builtin_amdgcn_s_setprio(1); _Pragma("unroll") for (int m = 0; m < 4; ++m) _Pragma("unroll") for (int n = 0; n < 2; ++n) _Pragma("unroll") for (int k = 0; k < 2; ++k) \
        acc[ai][bj][m][n] = __builtin_amdgcn_mfma_f32_16x16x32_bf16(Bt[n][k], At[m][k], acc[ai][bj][m][n], 0, 0, 0); __builtin_amdgcn_s_setprio(0); } while (0)
#define PG8_WAIT_V(n) asm volatile("s_waitcnt vmcnt(" #n ")" ::: "memory")
#define PG8_WAIT_L(n) asm volatile("s_waitcnt lgkmcnt(" #n ")" ::: "memory")
#define PG8_BAR __builtin_amdgcn_s_barrier()
#define PG8_SCHED __builtin_amdgcn_sched_barrier(0)
    Unit cur, nxt; int ui = 0;
    if (!S.next(0, cur)) return;
    f32x4 acc[2][2][4][2];
#pragma unroll
    for (int a = 0; a < 2; ++a)
#pragma unroll
        for (int b = 0; b < 2; ++b)
#pragma unroll
            for (int m = 0; m < 4; ++m)
#pragma unroll
                for (int n = 0; n < 2; ++n) acc[a][b][m][n] = (f32x4){0.f, 0.f, 0.f, 0.f};
    bf16x8 At[4][2], B0[2][2], B1[2][2];
    const char* cA = abase(g, cur.pm); const char* cB = (const char*)g.Bt + (size_t)cur.pn * tstep;
    S.a_ready(cur);
    if constexpr (SP2) {
        PG8_STAGE(PG8_SB(0, 0), cB, voffB); PG8_STAGE(PG8_SB(0, 1), cB + hstep, voffB); PG8_STAGE(PG8_SA(0, 0), cA, voffA); PG8_STAGE(PG8_SA(0, 1), cA + hsA, voffA);
        if (wr == 1) PG8_BAR;
        PG8_WAIT_V(2); PG8_BAR;
        PG8_STAGE(PG8_SB(1, 0), cB + kstep, voffB); PG8_STAGE(PG8_SA(1, 0), cA + kstep, voffA); PG8_STAGE(PG8_SB(1, 1), cB + hstep + kstep, voffB);
        PG8_WAIT_V(6); PG8_BAR;
    } else {
        PG8_STAGE(PG8_SB(0, 0), cB, voffB); PG8_STAGE(PG8_SA(0, 0), cA, voffA); PG8_STAGE(PG8_SB(0, 1), cB + hstep, voffB); PG8_STAGE(PG8_SA(0, 1), cA + hsA, voffA);
        if (wr == 1) PG8_BAR;
        PG8_WAIT_V(4); PG8_BAR;
        PG8_STAGE(PG8_SB(1, 0), cB + kstep, voffB); PG8_STAGE(PG8_SA(1, 0), cA + kstep, voffA); PG8_STAGE(PG8_SB(1, 1), cB + hstep + kstep, voffB);
        PG8_WAIT_V(6); PG8_BAR;
    }
    for (;;) {
        const bool has_next = S.next(ui + 1, nxt);
        const char* nA = has_next ? abase(g, nxt.pm) : cA; const char* nB = has_next ? (const char*)g.Bt + (size_t)nxt.pn * tstep : cB;
        for (int t = 0; t < nt; t += 2) {
            const bool last = (t == nt - 2);
            const char* a1 = cA + (size_t)(t + 1) * kstep;
            const char* a2 = last ? nA : cA + (size_t)(t + 2) * kstep; const char* b2 = last ? nB : cB + (size_t)(t + 2) * kstep;
            const char* a3 = a2 + kstep; const char* b3 = b2 + kstep;
            if (last && has_next) S.a_ready(nxt);
            if constexpr (SP2) {
            PG8_LDB(B0, 0, 0); PG8_LDB(B1, 0, 1); PG8_SCHED; PG8_LDA(At, 0, 0); PG8_STAGE(PG8_SA(1, 1), a1 + hsA, voffA);
            PG8_WAIT_V(8); PG8_WAIT_L(0); PG8_BAR; PG8_MMA(0, 0, At, B0); PG8_MMA(0, 1, At, B1); PG8_BAR; PG8_SCHED;
            PG8_LDA(At, 0, 1); PG8_STAGE(PG8_SB(0, 0), b2, voffB); PG8_STAGE(PG8_SB(0, 1), b2 + hstep, voffB); PG8_STAGE(PG8_SA(0, 0), a2, voffA);
            PG8_WAIT_V(8); PG8_WAIT_L(0); PG8_BAR; PG8_MMA(1, 0, At, B0); PG8_MMA(1, 1, At, B1); PG8_BAR; PG8_SCHED;
            PG8_LDB(B0, 1, 0); PG8_LDB(B1, 1, 1); PG8_SCHED; PG8_LDA(At, 1, 0); PG8_STAGE(PG8_SA(0, 1), a2 + hsA, voffA);
            PG8_WAIT_V(8); PG8_WAIT_L(0); PG8_BAR; PG8_MMA(0, 0, At, B0); PG8_MMA(0, 1, At, B1); PG8_BAR; PG8_SCHED;
            PG8_LDA(At, 1, 1); PG8_STAGE(PG8_SB(1, 0), b3, voffB); PG8_STAGE(PG8_SB(1, 1), b3 + hstep, voffB); PG8_STAGE(PG8_SA(1, 0), a3, voffA);
            PG8_WAIT_V(8); PG8_WAIT_L(0); PG8_BAR; PG8_MMA(1, 0, At, B0); PG8_MMA(1, 1, At, B1); PG8_BAR; PG8_SCHED;
            } else {
            PG8_LDB(B0, 0, 0); PG8_SCHED; PG8_LDA(At, 0, 0); PG8_STAGE(PG8_SA(1, 1), a1 + hsA, voffA);
            PG8_WAIT_L(8); PG8_BAR; PG8_WAIT_L(0); PG8_MMA(0, 0, At, B0); PG8_BAR; PG8_SCHED;
            PG8_LDB(B1, 0, 1); PG8_STAGE(PG8_SB(0, 0), b2, voffB);
            PG8_BAR; PG8_WAIT_L(0); PG8_MMA(0, 1, At, B1); PG8_BAR;
            PG8_LDA(At, 0, 1); PG8_STAGE(PG8_SA(0, 0), a2, voffA);
            PG8_BAR; PG8_WAIT_L(0); PG8_MMA(1, 0, At, B0); PG8_BAR; PG8_SCHED;
            PG8_STAGE(PG8_SB(0, 1), b2 + hstep, voffB);
            PG8_WAIT_V(6); PG8_BAR; PG8_MMA(1, 1, At, B1); PG8_BAR;
            PG8_LDB(B0, 1, 0); PG8_SCHED; PG8_LDA(At, 1, 0); PG8_STAGE(PG8_SA(0, 1), a2 + hsA, voffA);
            PG8_WAIT_L(8); PG8_BAR; PG8_WAIT_L(0); PG8_MMA(0, 0, At, B0); PG8_BAR; PG8_SCHED;
            PG8_LDB(B1, 1, 1); PG8_STAGE(PG8_SB(1, 0), b3, voffB);
            PG8_BAR; PG8_WAIT_L(0); PG8_MMA(0, 1, At, B1); PG8_BAR;
            PG8_LDA(At, 1, 1); PG8_STAGE(PG8_SA(1, 0), a3, voffA);
            PG8_BAR; PG8_WAIT_L(0); PG8_MMA(1, 0, At, B0); PG8_BAR; PG8_SCHED;
            PG8_STAGE(PG8_SB(1, 1), b3 + hstep, voffB);
            PG8_WAIT_V(6); PG8_BAR; PG8_MMA(1, 1, At, B1); PG8_BAR;
            }
        }
        if constexpr (ALIGN_EPI) { if (wr == 0) PG8_BAR; }
        if constexpr (!Epi::AFTER_DRAIN) { E(acc, cur, wr, wc, fr, fq); S.done(cur); }
        if (!has_next) break;
#pragma unroll
        for (int a = 0; a < 2; ++a)
#pragma unroll
            for (int b = 0; b < 2; ++b)
#pragma unroll
                for (int m = 0; m < 4; ++m)
#pragma unroll
                    for (int n = 0; n < 2; ++n) acc[a][b][m][n] = (f32x4){0.f, 0.f, 0.f, 0.f};
        cur = nxt; cA = nA; cB = nB; ++ui;
        if constexpr (ALIGN_EPI) { if (wr == 1) PG8_BAR; }
    }
    PG8_WAIT_V(0);
    if constexpr (!ALIGN_EPI) { if (wr == 0) PG8_BAR; }
    PG8_BAR;
    if constexpr (Epi::AFTER_DRAIN) { E.fused(acc, cur, wr, wc, fr, fq, lds, wid, lane); S.done(cur); }
#undef PG8_SA
#undef PG8_SB
#undef PG8_STAGE
#undef PG8_LDA
#undef PG8_LDB
#undef PG8_MMA
#undef PG8_WAIT_V
#undef PG8_WAIT_L
#undef PG8_BAR
#undef PG8_SCHED
}
}

struct Frame {
    LAS unsigned char* lds;
    int tid, lane, wave, G;
    const float* in[24];
    float* out;
    bf16_t *Wqkv, *Wo, *Wup, *Wdn, *Wgin, *Wgo;
    bf16_t *XN, *OB, *YB;
    bf16_t *R1;
    float *LA, *SSQ, *ropec, *ropes;
};
__device__ __forceinline__ float wave_sum(float v) {
#pragma unroll
    for (int o = 1; o < 64; o <<= 1) v += __shfl_xor(v, o);
    return v;
}
__device__ __forceinline__ float wave_max(float v) {
#pragma unroll
    for (int o = 1; o < 64; o <<= 1) v = fmaxf(v, __shfl_xor(v, o));
    return v;
}
#define LDS_WAIT() asm volatile("s_waitcnt lgkmcnt(0)" ::: "memory")


#define GAS __attribute__((address_space(1)))
#define RLX_AGENT __ATOMIC_RELAXED, __HIP_MEMORY_SCOPE_AGENT
#define XB_TMO      128
#define XB_XCNT(j)  (256  + 64 * (j))
#define XB_XSUB(j)  (1280 + 64 * (j))
#define XB_XGEN(j)  (2304 + 64 * (j))
#define XB_TOP      3328
#define XB_TOPGEN   3392
#define XCD_BAR_WORDS 3456
#define XB_SPIN_CAP (1u << 18)

__device__ __forceinline__ unsigned xb_ld(unsigned* p)              { return __hip_atomic_load(p, __ATOMIC_RELAXED, __HIP_MEMORY_SCOPE_AGENT); }
__device__ __forceinline__ unsigned xb_add(unsigned* p, unsigned v) { return __hip_atomic_fetch_add(p, v, __ATOMIC_RELAXED, __HIP_MEMORY_SCOPE_AGENT); }
__device__ __forceinline__ unsigned xb_xcc_id() { return (unsigned)__builtin_amdgcn_s_getreg((3 << 11) | 20) & 0xFu; }
#define XB_SPIN(cond, bar) do { unsigned _sp = 0; while (cond) { __builtin_amdgcn_s_sleep(1); \
    if ((++_sp & 255u) == 0u) { if (xb_ld(&(bar)[XB_TMO])) break; if (_sp > XB_SPIN_CAP) { atomicAdd(&(bar)[XB_TMO], 1u); break; } } } } while (0)

struct XcdBarrier {
    unsigned* bar; unsigned x;
    volatile LAS unsigned* st;
};

__device__ __forceinline__ XcdBarrier xcd_barrier_post(unsigned* bar, volatile LAS unsigned* st) {
    XcdBarrier b; b.bar = bar; b.x = xb_xcc_id(); b.st = st;
    if (threadIdx.x == 0) (void)xb_add(&bar[XB_XCNT(b.x)], 1u);
    return b;
}
__device__ __forceinline__ void xcd_barrier_complete(unsigned* bar, unsigned x, unsigned& nloc, unsigned& nx) {
    const unsigned G = gridDim.x * gridDim.y * gridDim.z;
    unsigned sum, cnt, mine, sp = 0u;
    for (;;) {
        sum = 0u; cnt = 0u; mine = 0u;
#pragma unroll
        for (unsigned j = 0; j < 16; ++j) { const unsigned c = xb_ld(&bar[XB_XCNT(j)]); sum += c; cnt += (c > 0u) ? 1u : 0u; mine = (j == x) ? c : mine; }
        if (sum == G) break;
        __builtin_amdgcn_s_sleep(1);
        if ((++sp & 255u) == 0u) { if (xb_ld(&bar[XB_TMO])) break; if (sp > XB_SPIN_CAP) { atomicAdd(&bar[XB_TMO], 1u); break; } }
    }
    nloc = mine > 0u ? mine : 1u; nx = cnt > 0u ? cnt : 1u;
}

__device__ __forceinline__ void xcd_barrier(const XcdBarrier& b) {
    asm volatile("s_waitcnt vmcnt(0)" ::: "memory");
    __syncthreads();
    if (threadIdx.x == 0) {
        unsigned* bar = b.bar;
        __builtin_amdgcn_s_waitcnt(0);
        unsigned nloc = b.st[0], nx = b.st[1];
        if (nloc == 0u) { xcd_barrier_complete(bar, b.x, nloc, nx); b.st[0] = nloc; b.st[1] = nx; }
        const unsigned old = xb_add(&bar[XB_XSUB(b.x)], 1u);
        const unsigned gen = old / nloc;
        if (old + 1u == (gen + 1u) * nloc) {
            __builtin_amdgcn_fence(__ATOMIC_RELEASE, "agent");
            asm volatile("s_waitcnt vmcnt(0)" ::: "memory");
            const unsigned og = xb_add(&bar[XB_TOP], 1u);
            const unsigned tg = og / nx;
            if (og + 1u == (tg + 1u) * nx) xb_add(&bar[XB_TOPGEN], 1u);
            else XB_SPIN(xb_ld(&bar[XB_TOPGEN]) == tg, bar);
            __builtin_amdgcn_fence(__ATOMIC_ACQUIRE, "agent");
            xb_add(&bar[XB_XGEN(b.x)], 1u);
            asm volatile("s_waitcnt vmcnt(0)" ::: "memory");
        } else {
            XB_SPIN(xb_ld(&bar[XB_XGEN(b.x)]) == gen, bar);
            __builtin_amdgcn_fence(__ATOMIC_ACQUIRE, "agent");
            asm volatile("s_waitcnt vmcnt(0)" ::: "memory");
        }
    }
    __syncthreads();
}
__device__ __forceinline__ void p0_transpose_item(const float* W, int K, int N, bf16_t* WT, int up, LAS float* scr, int item, int lane) {
    const int nblk = N / 32, kb = item / nblk, nb = item % nblk, k0 = 64 * kb, n0 = 32 * nb;
#pragma unroll 16
    for (int i = 0; i < 32; ++i) { const int kk = 2 * i + (lane >> 5); scr[kk * 33 + (lane & 31)] = W[(size_t)(k0 + kk) * N + n0 + (lane & 31)]; }
    LDS_WAIT(); asm volatile("" ::: "memory");
    int r0 = n0;
    if (up) { const int hi = n0 >= FF, c = n0 - hi * FF; r0 = 256 * (c >> 7) + 128 * hi + (c & 127); }
    const int c = lane & 7;
#pragma unroll
    for (int j = 0; j < 4; ++j) { const int n = (lane >> 3) + 8 * j; const LAS float* s = scr + (8 * c) * 33 + n;
        u32x4 o; o.x = cvt_pk_bf16(s[0 * 33], s[1 * 33]); o.y = cvt_pk_bf16(s[2 * 33], s[3 * 33]); o.z = cvt_pk_bf16(s[4 * 33], s[5 * 33]); o.w = cvt_pk_bf16(s[6 * 33], s[7 * 33]);
        *(u32x4*)(WT + (size_t)(r0 + n) * K + k0 + 8 * c) = o; }
    LDS_WAIT(); asm volatile("" ::: "memory");
}
__device__ __forceinline__ void p0_prologue(const Frame& F) {
    LAS float* scr = (LAS float*)(F.lds + F.wave * 16384);
    const int gw = blockIdx.x * 8 + F.wave, NGW = F.G * 8;
    constexpr int I_QKV = 16 * 40, I_O = 16 * 32, I_GIN = 16 * 96, I_UP = 16 * 176, I_DN = 44 * 32;
    constexpr int NITEMS = I_QKV + 2 * I_O + I_GIN + 2 * I_UP + 2 * I_DN;
    for (int it = gw; it < NITEMS; it += NGW) {
        int r = it;
        if (r < I_QKV) { p0_transpose_item(F.in[6], DM, NQKV, F.Wqkv, 0, scr, r, F.lane); continue; } r -= I_QKV;
        if (r < I_O) { p0_transpose_item(F.in[9], DM, DM, F.Wo, 0, scr, r, F.lane); continue; } r -= I_O;
        if (r < I_O) { p0_transpose_item(F.in[15], DM, DM, F.Wgo, 0, scr, r, F.lane); continue; } r -= I_O;
        if (r < I_GIN) { p0_transpose_item(F.in[10], DM, NPROJ, F.Wgin, 0, scr, r, F.lane); continue; } r -= I_GIN;
        if (r < 2 * I_UP) { const int l = r / I_UP; p0_transpose_item(F.in[16] + (size_t)l * DM * NUP, DM, NUP, F.Wup + (size_t)l * NUP * DM, 1, scr, r % I_UP, F.lane); continue; } r -= 2 * I_UP;
        { const int l = r / I_DN; p0_transpose_item(F.in[19] + (size_t)l * FF * DM, FF, DM, F.Wdn + (size_t)l * DM * FF, 0, scr, r % I_DN, F.lane); }
    }
    const int gt = blockIdx.x * 512 + F.tid, NGT = F.G * 512;
    for (int idx = gt; idx < 512 * 128; idx += NGT) { const int n = idx >> 7, k0 = (idx & 127) * 8; float s[8];
#pragma unroll
        for (int e = 0; e < 8; ++e) s[e] = 0.f;
        for (int r = 0; r < 16; ++r) { const float w2 = F.in[12][r * 512 + n];
#pragma unroll
            for (int e = 0; e < 8; ++e) s[e] += F.in[11][(k0 + e) * 16 + r] * w2; }
        u32x4 o; o.x = cvt_pk_bf16(s[0], s[1]); o.y = cvt_pk_bf16(s[2], s[3]); o.z = cvt_pk_bf16(s[4], s[5]); o.w = cvt_pk_bf16(s[6], s[7]);
        *(u32x4*)(F.Wgin + (size_t)(NPROJ + n) * DM + k0) = o; }
    for (int idx0 = gt; idx0 < (MP + NS) * 128; idx0 += 4 * NGT) { f32x4 a[4], c[4];
#pragma unroll
        for (int u = 0; u < 4; ++u) { const int idx = idx0 + u * NGT; if (idx < (MP + NS) * 128) { const int i = idx >> 7, cc = (idx & 127) * 8;
            const float* xp = (i < MP ? F.in[0] + (size_t)i * DM : F.in[1] + (size_t)(i - MP) * DM) + cc; a[u] = *(const f32x4*)xp; c[u] = *(const f32x4*)(xp + 4); } }
#pragma unroll
        for (int u = 0; u < 4; ++u) { const int idx = idx0 + u * NGT; if (idx < (MP + NS) * 128) { const int i = idx >> 7, cc = (idx & 127) * 8, r = i < MP ? i : SROW + (i - MP);
            u32x4 o; o.x = cvt_pk_bf16(a[u][0], a[u][1]); o.y = cvt_pk_bf16(a[u][2], a[u][3]); o.z = cvt_pk_bf16(c[u][0], c[u][1]); o.w = cvt_pk_bf16(c[u][2], c[u][3]);
            *(u32x4*)(F.XN + (size_t)r * DM + cc) = o; } }
    }
    for (int idx = gt; idx < 2049 * 32; idx += NGT) { const int p = idx >> 5, i = idx & 31;
        const float inv = (float)(1.0 / pow(10000.0, (double)i / 32.0)); const float pos = p < 2048 ? (float)p : 16384.f; const float ang = pos * inv;
        F.ropec[idx] = (float)cos((double)ang); F.ropes[idx] = (float)sin((double)ang); }
}

__device__ __forceinline__ void ln_phase(const Frame& F, const float* g, const float* b, bool final) {
    const int gw = blockIdx.x * 8 + F.wave, NGW = F.G * 8, lane = F.lane;
    f32x4 gv[4], bv[4];
#pragma unroll
    for (int j = 0; j < 2; ++j) { gv[2 * j] = *(const f32x4*)(g + 8 * lane + 512 * j); gv[2 * j + 1] = *(const f32x4*)(g + 8 * lane + 512 * j + 4); bv[2 * j] = *(const f32x4*)(b + 8 * lane + 512 * j); bv[2 * j + 1] = *(const f32x4*)(b + 8 * lane + 512 * j + 4); }
    for (int i = 2 * gw; i < MP + NS; i += 2 * NGW) {
        u32x4 raw[2][2]; int rr[2];
#pragma unroll
        for (int q = 0; q < 2; ++q) { const int ii = i + q; rr[q] = ii < MP ? ii : SROW + (ii - MP);
            const bf16_t* yp = F.YB + (size_t)rr[q] * DM + 8 * lane; raw[q][0] = *(const u32x4*)yp; raw[q][1] = *(const u32x4*)(yp + 512); }
        f32x4 v[2][4]; float s[2] = {0.f, 0.f};
#pragma unroll
        for (int q = 0; q < 2; ++q)
#pragma unroll
            for (int j = 0; j < 2; ++j) { const u32x4 rw = raw[q][j]; v[q][2 * j] = (f32x4){bflo(rw[0]), bfhi(rw[0]), bflo(rw[1]), bfhi(rw[1])}; v[q][2 * j + 1] = (f32x4){bflo(rw[2]), bfhi(rw[2]), bflo(rw[3]), bfhi(rw[3])}; }
#pragma unroll
        for (int q = 0; q < 2; ++q)
#pragma unroll
            for (int j = 0; j < 4; ++j) s[q] += (v[q][j][0] + v[q][j][1]) + (v[q][j][2] + v[q][j][3]);
#pragma unroll
        for (int o = 1; o < 64; o <<= 1) { s[0] += __shfl_xor(s[0], o); s[1] += __shfl_xor(s[1], o); }
        float s2[2] = {0.f, 0.f};
#pragma unroll
        for (int q = 0; q < 2; ++q) { const float mean = s[q] * (1.f / DM);
#pragma unroll
            for (int j = 0; j < 4; ++j) { v[q][j] = v[q][j] - mean; s2[q] += (v[q][j][0] * v[q][j][0] + v[q][j][1] * v[q][j][1]) + (v[q][j][2] * v[q][j][2] + v[q][j][3] * v[q][j][3]); } }
#pragma unroll
        for (int o = 1; o < 64; o <<= 1) { s2[0] += __shfl_xor(s2[0], o); s2[1] += __shfl_xor(s2[1], o); }
#pragma unroll
        for (int q = 0; q < 2; ++q) { const float rstd = 1.f / sqrtf(s2[q] * (1.f / DM) + LN_EPS);
            f32x4 o[4];
#pragma unroll
            for (int j = 0; j < 4; ++j) o[j] = v[q][j] * rstd * gv[j] + bv[j];
            if (final) { float* row = F.out + (size_t)(i + q) * DM + 8 * lane;
                *(f32x4*)row = o[0]; *(f32x4*)(row + 4) = o[1]; *(f32x4*)(row + 512) = o[2]; *(f32x4*)(row + 516) = o[3]; }
            else { bf16_t* xr = F.XN + (size_t)rr[q] * DM + 8 * lane;
                *(u32x4*)xr = (u32x4){cvt_pk_bf16(o[0][0], o[0][1]), cvt_pk_bf16(o[0][2], o[0][3]), cvt_pk_bf16(o[1][0], o[1][1]), cvt_pk_bf16(o[1][2], o[1][3])};
                *(u32x4*)(xr + 512) = (u32x4){cvt_pk_bf16(o[2][0], o[2][1]), cvt_pk_bf16(o[2][2], o[2][3]), cvt_pk_bf16(o[3][0], o[3][1]), cvt_pk_bf16(o[3][2], o[3][3])}; } }
    }
}

__device__ __forceinline__ void attn_prompt_unit(const Frame& F, int b, int kvh, int qb) {
    LAS bf16_t* Ks = (LAS bf16_t*)F.lds;
    LAS bf16_t* Vt = (LAS bf16_t*)(F.lds + 36864);
    const int tid = F.tid, lane = F.lane, w = F.wave, fr = lane & 15, g = lane >> 4;
    const bf16_t* QKV = F.R1; const bool last = (qb == 15);
#pragma unroll
    for (int rep = 0; rep < 2; ++rep) {
        const int idx = tid + 512 * rep, s = idx >> 2, d0 = 8 * (idx & 3), tk = qb * 128 - 128 + s;
        u32x4 o0 = {0u, 0u, 0u, 0u}, o1 = {0u, 0u, 0u, 0u};
        if (tk >= 0) {
            const bf16_t* kp = QKV + (size_t)(b * SEQ + tk) * NQKV + 1024 + kvh * 64 + d0;
            const u32x4 k0 = *(const u32x4*)kp, k1 = *(const u32x4*)(kp + 32);
            const float* cp = F.ropec + tk * 32 + d0; const float* sp = F.ropes + tk * 32 + d0;
            const f32x4 c0 = *(const f32x4*)cp, c1 = *(const f32x4*)(cp + 4), s0 = *(const f32x4*)sp, s1 = *(const f32x4*)(sp + 4);
            float r0[8], r1[8];
#pragma unroll
            for (int e = 0; e < 4; ++e) {
                const float xa = bflo(k0[e]), xb = bfhi(k0[e]), ya = bflo(k1[e]), yb = bfhi(k1[e]);
                const float ca = e < 2 ? c0[2 * e] : c1[2 * e - 4], cb = e < 2 ? c0[2 * e + 1] : c1[2 * e - 3];
                const float sa = e < 2 ? s0[2 * e] : s1[2 * e - 4], sb = e < 2 ? s0[2 * e + 1] : s1[2 * e - 3];
                r0[2 * e] = xa * ca - ya * sa; r0[2 * e + 1] = xb * cb - yb * sb; r1[2 * e] = ya * ca + xa * sa; r1[2 * e + 1] = yb * cb + xb * sb;
            }
            o0 = (u32x4){cvt_pk_bf16(r0[0], r0[1]), cvt_pk_bf16(r0[2], r0[3]), cvt_pk_bf16(r0[4], r0[5]), cvt_pk_bf16(r0[6], r0[7])};
            o1 = (u32x4){cvt_pk_bf16(r1[0], r1[1]), cvt_pk_bf16(r1[2], r1[3]), cvt_pk_bf16(r1[4], r1[5]), cvt_pk_bf16(r1[6], r1[7])};
            if (last && s >= 128) { float* ko = F.out + O_KP + ((size_t)(b * 128 + s - 128) * 2 + kvh) * 64 + d0;
                *(f32x4*)ko = (f32x4){r0[0], r0[1], r0[2], r0[3]}; *(f32x4*)(ko + 4) = (f32x4){r0[4], r0[5], r0[6], r0[7]};
                *(f32x4*)(ko + 32) = (f32x4){r1[0], r1[1], r1[2], r1[3]}; *(f32x4*)(ko + 36) = (f32x4){r1[4], r1[5], r1[6], r1[7]}; }
        }
        *(LAS u32x4*)(Ks + s * 72 + d0) = o0; *(LAS u32x4*)(Ks + s * 72 + 32 + d0) = o1;
    }
#pragma unroll
    for (int rep = 0; rep < 2; ++rep) {
        const int dp = lane & 31, kq = (lane >> 5) + 2 * w + 16 * rep;
        unsigned vv[8];
#pragma unroll
        for (int i = 0; i < 8; ++i) { const int s = 8 * kq + i, tk = qb * 128 - 128 + s; vv[i] = 0u;
            if (tk >= 0) { vv[i] = *(const unsigned*)(QKV + (size_t)(b * SEQ + tk) * NQKV + 1152 + kvh * 64 + 2 * dp);
                if (last && s >= 128) *(f32x2*)(F.out + O_VP + ((size_t)(b * 128 + s - 128) * 2 + kvh) * 64 + 2 * dp) = (f32x2){bflo(vv[i]), bfhi(vv[i])}; } }
        u32x4 lo, hi;
#pragma unroll
        for (int i = 0; i < 4; ++i) { lo[i] = (vv[2 * i] & 0xffffu) | (vv[2 * i + 1] << 16); hi[i] = (vv[2 * i] >> 16) | (vv[2 * i + 1] & 0xffff0000u); }
        *(LAS u32x4*)(Vt + (2 * dp) * 272 + 8 * kq) = lo; *(LAS u32x4*)(Vt + (2 * dp + 1) * 272 + 8 * kq) = hi;
    }
    __syncthreads();
    constexpr float QSC = 0.125f * 1.4426950408889634f;
    const int h = kvh * 8 + w; const float sink = F.in[8][h] * 1.4426950408889634f;
    u32x4 nq0, nq1; f32x4 nc0, nc1, ns0, ns1;
#define ATT_QLOAD(qg_) do { const int pos_ = qb * 128 + 16 * (qg_) + fr; const bf16_t* qp = QKV + (size_t)(b * SEQ + pos_) * NQKV + h * 64 + 8 * g; nq0 = *(const u32x4*)qp; nq1 = *(const u32x4*)(qp + 32); \
        const float* cp = F.ropec + pos_ * 32 + 8 * g; const float* sp = F.ropes + pos_ * 32 + 8 * g; nc0 = *(const f32x4*)cp; nc1 = *(const f32x4*)(cp + 4); ns0 = *(const f32x4*)sp; ns1 = *(const f32x4*)(sp + 4); } while (0)
    ATT_QLOAD(0);
    for (int qg = 0; qg < 8; ++qg) {
        const int i = 16 * qg + fr, pos = qb * 128 + i; const size_t rq = (size_t)(b * SEQ + pos);
        bf16x8 Bq0, Bq1;
        { const u32x4 q0 = nq0, q1 = nq1; const f32x4 c0 = nc0, c1 = nc1, s0 = ns0, s1 = ns1;
            if (qg < 7) ATT_QLOAD(qg + 1);
            float r0[8], r1[8];
#pragma unroll
            for (int e = 0; e < 4; ++e) {
                const float xa = bflo(q0[e]), xb = bfhi(q0[e]), ya = bflo(q1[e]), yb = bfhi(q1[e]);
                const float ca = e < 2 ? c0[2 * e] : c1[2 * e - 4], cb = e < 2 ? c0[2 * e + 1] : c1[2 * e - 3];
                const float sa = e < 2 ? s0[2 * e] : s1[2 * e - 4], sb = e < 2 ? s0[2 * e + 1] : s1[2 * e - 3];
                r0[2 * e] = (xa * ca - ya * sa) * QSC; r0[2 * e + 1] = (xb * cb - yb * sb) * QSC; r1[2 * e] = (ya * ca + xa * sa) * QSC; r1[2 * e + 1] = (yb * cb + xb * sb) * QSC;
            }
            Bq0 = mk8(cvt_pk_bf16(r0[0], r0[1]), cvt_pk_bf16(r0[2], r0[3]), cvt_pk_bf16(r0[4], r0[5]), cvt_pk_bf16(r0[6], r0[7]));
            Bq1 = mk8(cvt_pk_bf16(r1[0], r1[1]), cvt_pk_bf16(r1[2], r1[3]), cvt_pk_bf16(r1[4], r1[5]), cvt_pk_bf16(r1[6], r1[7])); }
        f32x4 sc[9]; float mx = -1e30f;
#pragma unroll
        for (int tt = 0; tt < 9; ++tt) {
            const LAS bf16_t* kr = Ks + ((qg + tt) * 16 + fr) * 72 + 8 * g;
            f32x4 a = {0.f, 0.f, 0.f, 0.f};
            a = mfma16(*(const LAS bf16x8*)kr, Bq0, a); a = mfma16(*(const LAS bf16x8*)(kr + 32), Bq1, a);
            if (tt == 0) {
#pragma unroll
                for (int e = 0; e < 4; ++e) a[e] = (4 * g + e - fr >= 1) ? a[e] : -1e30f; }
            if (tt == 8) {
#pragma unroll
                for (int e = 0; e < 4; ++e) a[e] = (4 * g + e - fr <= 0) ? a[e] : -1e30f; }
            if (qb == 0 && qg + tt < 8) a = (f32x4){-1e30f, -1e30f, -1e30f, -1e30f};
            mx = fmaxf(fmaxf(mx, fmaxf(a[0], a[1])), fmaxf(a[2], a[3]));
            sc[tt] = a;
        }
        mx = fmaxf(mx, __shfl_xor(mx, 16)); mx = fmaxf(mx, __shfl_xor(mx, 32)); mx = fmaxf(mx, sink);
        float sum = 0.f;
#pragma unroll
        for (int tt = 0; tt < 9; ++tt)
#pragma unroll
            for (int e = 0; e < 4; ++e) { const float p = __builtin_amdgcn_exp2f(sc[tt][e] - mx); sc[tt][e] = p; sum += p; }
        sum += __shfl_xor(sum, 16); sum += __shfl_xor(sum, 32);
        const float inv = 1.f / (sum + __builtin_amdgcn_exp2f(sink - mx));
        bf16x8 P[5];
#pragma unroll
        for (int ks = 0; ks < 5; ++ks) {
            const f32x4 lo = sc[2 * ks]; f32x4 hi = {0.f, 0.f, 0.f, 0.f}; if (2 * ks + 1 < 9) hi = sc[(2 * ks + 1) < 9 ? 2 * ks + 1 : 8];
            P[ks] = mk8(cvt_pk_bf16(lo[0], lo[1]), cvt_pk_bf16(lo[2], lo[3]), cvt_pk_bf16(hi[0], hi[1]), cvt_pk_bf16(hi[2], hi[3]));
        }
        bf16_t* orow = F.XN + rq * DM + h * 64 + 4 * g;
#pragma unroll
        for (int nt = 0; nt < 4; ++nt) {
            const LAS bf16_t* vr = Vt + (16 * nt + fr) * 272 + 4 * g;
            f32x4 o = {0.f, 0.f, 0.f, 0.f};
#pragma unroll
            for (int ks = 0; ks < 5; ++ks) { const int k0 = qg + 2 * ks, k1 = (k0 + 1) < 16 ? (k0 + 1) : 15;
                const u32x2 lo = *(const LAS u32x2*)(vr + k0 * 16), hi = *(const LAS u32x2*)(vr + k1 * 16);
                o = mfma16(mk8(lo.x, lo.y, hi.x, hi.y), P[ks], o); }
            u32x2 wv; wv.x = cvt_pk_bf16(o[0] * inv, o[1] * inv); wv.y = cvt_pk_bf16(o[2] * inv, o[3] * inv);
            *(u32x2*)(orow + 16 * nt) = wv;
        }
    }
#undef ATT_QLOAD
    __syncthreads();
}
__device__ __forceinline__ void attn_sample_unit(const Frame& F, int b) {
    LAS bf16_t* Kc = (LAS bf16_t*)F.lds;
    LAS bf16_t* Vc = (LAS bf16_t*)(F.lds + 34816);
    LAS float* qs = (LAS float*)(F.lds + 69632);
    LAS float* ps = (LAS float*)(F.lds + 73728);
    const int tid = F.tid, lane = F.lane, w = F.wave;
    const float* ck = F.in[2] + (size_t)b * 128 * 128; const float* cv = F.in[3] + (size_t)b * 128 * 128;
    float* nk = F.out + O_KS + (size_t)b * 128 * 128; float* nv = F.out + O_VS + (size_t)b * 128 * 128;
#pragma unroll
    for (int half = 0; half < 2; ++half) { f32x4 kk[4], vv[4];
#pragma unroll
        for (int it = 0; it < 4; ++it) { const int idx = tid + 512 * (4 * half + it); if (idx < 127 * 32) { const int s = 1 + (idx >> 5), c4 = 4 * (idx & 31); kk[it] = *(const f32x4*)(ck + s * 128 + c4); vv[it] = *(const f32x4*)(cv + s * 128 + c4); } }
#pragma unroll
        for (int it = 0; it < 4; ++it) { const int idx = tid + 512 * (4 * half + it); if (idx < 127 * 32) { const int s = 1 + (idx >> 5), c4 = 4 * (idx & 31);
            *(f32x4*)(nk + (s - 1) * 128 + c4) = kk[it]; *(f32x4*)(nv + (s - 1) * 128 + c4) = vv[it];
            *(LAS u32x2*)(Kc + (s - 1) * 136 + c4) = (u32x2){cvt_pk_bf16(kk[it][0], kk[it][1]), cvt_pk_bf16(kk[it][2], kk[it][3])};
            *(LAS u32x2*)(Vc + (s - 1) * 136 + c4) = (u32x2){cvt_pk_bf16(vv[it][0], vv[it][1]), cvt_pk_bf16(vv[it][2], vv[it][3])}; } } }
    const int row = SROW + b; const bf16_t* qrow = F.R1 + (size_t)row * NQKV;
    { const int h = tid >> 5, dd = tid & 31; const float q0 = bf2f(qrow[h * 64 + dd]), q1 = bf2f(qrow[h * 64 + dd + 32]);
        const float c = F.ropec[2048 * 32 + dd], s = F.ropes[2048 * 32 + dd];
        qs[h * 64 + dd] = (q0 * c - q1 * s) * 0.125f; qs[h * 64 + dd + 32] = (q1 * c + q0 * s) * 0.125f; }
    if (tid < 64) { const int kvh = tid >> 5, dd = tid & 31; const float k0 = bf2f(qrow[1024 + kvh * 64 + dd]), k1 = bf2f(qrow[1024 + kvh * 64 + dd + 32]);
        const float c = F.ropec[2048 * 32 + dd], s = F.ropes[2048 * 32 + dd]; const float r0 = k0 * c - k1 * s, r1 = k1 * c + k0 * s;
        nk[127 * 128 + kvh * 64 + dd] = r0; nk[127 * 128 + kvh * 64 + dd + 32] = r1; Kc[127 * 136 + kvh * 64 + dd] = f2bf(r0); Kc[127 * 136 + kvh * 64 + dd + 32] = f2bf(r1); }
    else if (tid < 192) { const int j = tid - 64; const bf16_t vb = qrow[1152 + j]; nv[127 * 128 + j] = bf2f(vb); Vc[127 * 136 + j] = vb; }
    __syncthreads();
#pragma unroll
    for (int r = 0; r < 4; ++r) { const int idx = tid + 512 * r, h = idx >> 7, s = idx & 127, kvh = h >> 3; float dot = 0.f;
#pragma unroll
        for (int c = 0; c < 8; ++c) { const u32x4 kk = *(const LAS u32x4*)(Kc + s * 136 + kvh * 64 + 8 * c); const f32x4 qa = *(const LAS f32x4*)(qs + h * 64 + 8 * c), qb = *(const LAS f32x4*)(qs + h * 64 + 8 * c + 4);
            dot += bflo(kk[0]) * qa[0] + bfhi(kk[0]) * qa[1] + bflo(kk[1]) * qa[2] + bfhi(kk[1]) * qa[3] + bflo(kk[2]) * qb[0] + bfhi(kk[2]) * qb[1] + bflo(kk[3]) * qb[2] + bfhi(kk[3]) * qb[3]; }
        ps[h * 128 + s] = dot; }
    __syncthreads();
#pragma unroll
    for (int x = 0; x < 2; ++x) { const int hh = w + 8 * x; const float sink = F.in[8][hh];
        const float v0 = ps[hh * 128 + lane], v1 = ps[hh * 128 + 64 + lane];
        const float m = fmaxf(wave_max(fmaxf(v0, v1)), sink); const float e0 = __expf(v0 - m), e1 = __expf(v1 - m);
        const float inv = 1.f / (wave_sum(e0 + e1) + __expf(sink - m));
        ps[hh * 128 + lane] = e0 * inv; ps[hh * 128 + 64 + lane] = e1 * inv; }
    __syncthreads();
    { const int h = tid >> 5, dp = tid & 31, kvh = h >> 3; float a0 = 0.f, a1 = 0.f;
#pragma unroll 4
        for (int s4 = 0; s4 < 128; s4 += 4) { const f32x4 p = *(const LAS f32x4*)(ps + h * 128 + s4);
#pragma unroll
            for (int x = 0; x < 4; ++x) { const unsigned vv = *(const LAS unsigned*)(Vc + (s4 + x) * 136 + kvh * 64 + 2 * dp); a0 += p[x] * bflo(vv); a1 += p[x] * bfhi(vv); } }
        *(unsigned*)(F.XN + (size_t)row * DM + h * 64 + 2 * dp) = cvt_pk_bf16(a0, a1); }
    __syncthreads();
}

__device__ __forceinline__ void gla_prompt_unit(const Frame& F, int b, int h, int vs) {
    constexpr int BUFB = 67584;
    LAS float* seg = (LAS float*)(F.lds + 2 * BUFB);
    LAS float* ssl = (LAS float*)(F.lds + 2 * BUFB + 4096);
    const int lane = F.lane, w = F.wave, fr = lane & 15, g = lane >> 4, vt = w & 3, th = w >> 2;
    const bf16_t* P = F.R1; const float* LA = F.LA;
    f32x4 S[8];
#pragma unroll
    for (int i = 0; i < 8; ++i) S[i] = (f32x4){0.f, 0.f, 0.f, 0.f};
    f32x2 rla[8]; unsigned rq[8], rk[8], rv[4];
    const int vjp = lane & 31, vtq = (lane >> 5) + 2 * w;
#define GLA_LOAD(c) do { const int row0_ = b * SEQ + 64 * (c); _Pragma("unroll") for (int i = 0; i < 8; ++i) { const size_t ro = (size_t)(row0_ + 8 * w + i); \
        rla[i] = *(const f32x2*)(LA + ro * 512 + h * 128 + 2 * lane); rq[i] = *(const unsigned*)(P + ro * NPROJ + h * 128 + 2 * lane); rk[i] = *(const unsigned*)(P + ro * NPROJ + 512 + h * 128 + 2 * lane); } \
        _Pragma("unroll") for (int i = 0; i < 4; ++i) rv[i] = *(const unsigned*)(P + (size_t)(row0_ + 4 * vtq + i) * NPROJ + 1024 + h * 256 + vs * 64 + 2 * vjp); } while (0)
#define GLA_SSQ(c) do { if (w == 0) F.SSQ[(size_t)(b * SEQ + 64 * (c) + lane) * 16 + h * 4 + vs] = (ssl[lane] + ssl[64 + lane]) + (ssl[128 + lane] + ssl[192 + lane]); } while (0)
    GLA_LOAD(0);
    for (int c = 0; c < 32; ++c) {
        const int row0 = b * SEQ + 64 * c;
        LAS unsigned char* bufp = F.lds + (c & 1) * BUFB;
        LAS bf16_t* Qin = (LAS bf16_t*)bufp; LAS bf16_t* Kin = (LAS bf16_t*)(bufp + 17408); LAS bf16_t* KoT = (LAS bf16_t*)(bufp + 34816); LAS bf16_t* Vt = (LAS bf16_t*)(bufp + 53248); LAS float* dec = (LAS float*)(bufp + 66560);
        float c0[8], c1[8]; float run0 = 0.f, run1 = 0.f;
#pragma unroll
        for (int i = 0; i < 8; ++i) { run0 += rla[i].x; run1 += rla[i].y; c0[i] = run0; c1[i] = run1; }
        *(LAS f32x2*)(seg + w * 128 + 2 * lane) = (f32x2){run0, run1};
        __syncthreads();
        if (c > 0) GLA_SSQ(c - 1);
        float pre0 = 0.f, pre1 = 0.f, tot0 = 0.f, tot1 = 0.f;
#pragma unroll
        for (int x = 0; x < 8; ++x) { const f32x2 sv = *(const LAS f32x2*)(seg + x * 128 + 2 * lane); tot0 += sv.x; tot1 += sv.y; if (x < w) { pre0 += sv.x; pre1 += sv.y; } }
        { const float et0 = __expf(tot0), et1 = __expf(tot1); float ko0[8], ko1[8];
#pragma unroll
            for (int i = 0; i < 8; ++i) { const int t = 8 * w + i; const float e0 = __expf(pre0 + c0[i]), e1 = __expf(pre1 + c1[i]), i0 = __builtin_amdgcn_rcpf(e0), i1 = __builtin_amdgcn_rcpf(e1);
                const float q0 = bflo(rq[i]), q1 = bfhi(rq[i]), k0 = bflo(rk[i]) * i0, k1 = bfhi(rk[i]) * i1;
                *(LAS unsigned*)(Qin + t * 136 + 2 * lane) = cvt_pk_bf16(q0 * QS_GLA * e0, q1 * QS_GLA * e1);
                *(LAS unsigned*)(Kin + t * 136 + 2 * lane) = cvt_pk_bf16(k0, k1);
                ko0[i] = k0 * et0; ko1[i] = k1 * et1; }
            *(LAS u32x4*)(KoT + (2 * lane) * 72 + 8 * w) = (u32x4){cvt_pk_bf16(ko0[0], ko0[1]), cvt_pk_bf16(ko0[2], ko0[3]), cvt_pk_bf16(ko0[4], ko0[5]), cvt_pk_bf16(ko0[6], ko0[7])};
            *(LAS u32x4*)(KoT + (2 * lane + 1) * 72 + 8 * w) = (u32x4){cvt_pk_bf16(ko1[0], ko1[1]), cvt_pk_bf16(ko1[2], ko1[3]), cvt_pk_bf16(ko1[4], ko1[5]), cvt_pk_bf16(ko1[6], ko1[7])};
            if (w == 0) *(LAS f32x2*)(dec + 2 * lane) = (f32x2){et0, et1}; }
        { u32x2 lo, hi;
            lo.x = (rv[0] & 0xffffu) | (rv[1] << 16); lo.y = (rv[2] & 0xffffu) | (rv[3] << 16); hi.x = (rv[0] >> 16) | (rv[1] & 0xffff0000u); hi.y = (rv[2] >> 16) | (rv[3] & 0xffff0000u);
            *(LAS u32x2*)(Vt + (2 * vjp) * 72 + 4 * vtq) = lo; *(LAS u32x2*)(Vt + (2 * vjp + 1) * 72 + 4 * vtq) = hi; }
        __syncthreads();
        if (c < 31) GLA_LOAD(c + 1);
#pragma unroll
        for (int ti = 0; ti < 2; ++ti) {
            const int tt = th == 0 ? (ti == 0 ? 0 : 3) : (ti == 0 ? 1 : 2);
            f32x4 o = {0.f, 0.f, 0.f, 0.f};
            const LAS bf16_t* qrow = Qin + (tt * 16 + fr) * 136;
#pragma unroll
            for (int ks = 0; ks < 4; ++ks) {
                const bf16x8 A = mk8(cvt_pk_bf16(S[2 * ks][0], S[2 * ks][1]), cvt_pk_bf16(S[2 * ks][2], S[2 * ks][3]), cvt_pk_bf16(S[2 * ks + 1][0], S[2 * ks + 1][1]), cvt_pk_bf16(S[2 * ks + 1][2], S[2 * ks + 1][3]));
                const u32x2 blo = *(const LAS u32x2*)(qrow + (2 * ks) * 16 + 4 * g), bhi = *(const LAS u32x2*)(qrow + (2 * ks + 1) * 16 + 4 * g);
                o = mfma16(A, mk8(blo.x, blo.y, bhi.x, bhi.y), o);
            }
#pragma unroll
            for (int sp = 0; sp < 2; ++sp) {
                if (2 * sp <= tt) {
                    f32x4 at[2];
#pragma unroll
                    for (int x = 0; x < 2; ++x) { const int st = 2 * sp + x; at[x] = (f32x4){0.f, 0.f, 0.f, 0.f};
                        if (st <= tt) { const LAS bf16_t* kr = Kin + (st * 16 + fr) * 136 + 8 * g;
#pragma unroll
                            for (int ks = 0; ks < 4; ++ks) at[x] = mfma16(*(const LAS bf16x8*)(kr + 32 * ks), *(const LAS bf16x8*)(qrow + 8 * g + 32 * ks), at[x]);
                            if (st == tt) {
#pragma unroll
                                for (int e = 0; e < 4; ++e) if (4 * g + e > fr) at[x][e] = 0.f; } } }
                    const LAS bf16_t* vr = Vt + (vt * 16 + fr) * 72 + 4 * g;
                    const u32x2 alo = *(const LAS u32x2*)(vr + (2 * sp) * 16), ahi = *(const LAS u32x2*)(vr + (2 * sp + 1) * 16);
                    o = mfma16(mk8(alo.x, alo.y, ahi.x, ahi.y), mk8(cvt_pk_bf16(at[0][0], at[0][1]), cvt_pk_bf16(at[0][2], at[0][3]), cvt_pk_bf16(at[1][0], at[1][1]), cvt_pk_bf16(at[1][2], at[1][3])), o);
                }
            }
            const int t = tt * 16 + fr;
            u32x2 wv; wv.x = cvt_pk_bf16(o[0], o[1]); wv.y = cvt_pk_bf16(o[2], o[3]);
            *(u32x2*)(F.OB + (size_t)(row0 + t) * DM + h * 256 + vs * 64 + vt * 16 + 4 * g) = wv;
            float ss = (o[0] * o[0] + o[1] * o[1]) + (o[2] * o[2] + o[3] * o[3]);
            ss += __shfl_xor(ss, 16); ss += __shfl_xor(ss, 32);
            if (g == 0) ssl[vt * 64 + t] = ss;
        }
#pragma unroll
        for (int dt = 0; dt < 8; ++dt) {
            const f32x4 dv = *(const LAS f32x4*)(dec + dt * 16 + 4 * g);
            f32x4 acc = S[dt] * dv;
            const LAS bf16_t* ar = KoT + (dt * 16 + fr) * 72 + 8 * g; const LAS bf16_t* br = Vt + (vt * 16 + fr) * 72 + 8 * g;
            acc = mfma16(*(const LAS bf16x8*)ar, *(const LAS bf16x8*)br, acc); acc = mfma16(*(const LAS bf16x8*)(ar + 32), *(const LAS bf16x8*)(br + 32), acc);
            S[dt] = acc;
        }
    }
    __syncthreads();
    GLA_SSQ(31);
#undef GLA_LOAD
#undef GLA_SSQ
    if (th == 0) {
        float* so = F.out + O_GP + ((size_t)(b * 4 + h) * 128) * 256 + vs * 64 + vt * 16 + fr;
#pragma unroll
        for (int dt = 0; dt < 8; ++dt)
#pragma unroll
            for (int e = 0; e < 4; ++e) so[(size_t)(dt * 16 + 4 * g + e) * 256] = S[dt][e];
    }
    __syncthreads();
}
__device__ __forceinline__ void gla_sample_unit(const Frame& F, int b, int h) {
    LAS float* red = (LAS float*)F.lds;
    LAS float* ssr = red + 2048;
    const int tid = F.tid, lane = F.lane, w = F.wave;
    const int row = SROW + b; const bf16_t* pr = F.R1 + (size_t)row * NPROJ; const float* la = F.LA + (size_t)row * 512 + h * 128;
    const u32x2 vv = *(const u32x2*)(pr + 1024 + h * 256 + 4 * lane); const f32x4 v4 = {bflo(vv.x), bfhi(vv.x), bflo(vv.y), bfhi(vv.y)};
    const float* s0 = F.in[4] + ((size_t)(b * 4 + h) * 128) * 256 + 4 * lane; float* s1 = F.out + O_GS + ((size_t)(b * 4 + h) * 128) * 256 + 4 * lane;
    f32x4 o4 = {0.f, 0.f, 0.f, 0.f};
    f32x4 st[16];
#pragma unroll
    for (int i = 0; i < 16; ++i) st[i] = *(const f32x4*)(s0 + (size_t)(16 * w + i) * 256);
#pragma unroll
    for (int i = 0; i < 16; ++i) { const int d = 16 * w + i; const float a = __expf(la[d]), kd = bf2f(pr[512 + h * 128 + d]), qd = bf2f(pr[h * 128 + d]) * QS_GLA;
        const f32x4 s = st[i] * a + v4 * kd; *(f32x4*)(s1 + (size_t)d * 256) = s; o4 += s * qd; }
    *(LAS f32x4*)(red + w * 256 + 4 * lane) = o4;
    __syncthreads();
    float o = 0.f, ss = 0.f;
    if (tid < 256) {
#pragma unroll
        for (int x = 0; x < 8; ++x) o += red[x * 256 + tid];
        F.OB[(size_t)row * DM + h * 256 + tid] = f2bf(o); ss = o * o; }
    ss = wave_sum(ss); if (lane == 0) ssr[w] = ss;
    __syncthreads();
    if (tid == 0) *(f32x4*)(F.SSQ + (size_t)row * 16 + h * 4) = (f32x4){(ssr[0] + ssr[1]) + (ssr[2] + ssr[3]), 0.f, 0.f, 0.f};
    __syncthreads();
}
__device__ __forceinline__ void gla_norm_phase(const Frame& F) {
    const int gw = blockIdx.x * 8 + F.wave, NGW = F.G * 8, lane = F.lane, hh = lane >> 4;
    f32x4 ng[4];
#pragma unroll
    for (int j = 0; j < 4; ++j) ng[j] = *(const f32x4*)(F.in[14] + (lane & 15) * 16 + 4 * j);
    for (int i = 2 * gw; i < MP + NS; i += 2 * NGW) {
        u32x4 ov[2][2], gv[2][2]; f32x4 sq[2]; bf16_t* op[2];
#pragma unroll
        for (int q = 0; q < 2; ++q) { const int ii = i + q, r = ii < MP ? ii : SROW + (ii - MP);
            sq[q] = *(const f32x4*)(F.SSQ + (size_t)r * 16 + hh * 4);
            op[q] = F.OB + (size_t)r * DM + lane * 16; const bf16_t* gp = F.R1 + (size_t)r * NPROJ + 2048 + lane * 16;
            ov[q][0] = *(const u32x4*)op[q]; ov[q][1] = *(const u32x4*)(op[q] + 8); gv[q][0] = *(const u32x4*)gp; gv[q][1] = *(const u32x4*)(gp + 8); }
#pragma unroll
        for (int q = 0; q < 2; ++q) { const float rs = 1.f / sqrtf(((sq[q][0] + sq[q][1]) + (sq[q][2] + sq[q][3])) * (1.f / 256.f) + 1e-6f);
#pragma unroll
            for (int x = 0; x < 2; ++x) { u32x4 w;
#pragma unroll
                for (int e = 0; e < 4; ++e) { const float o0 = bflo(ov[q][x][e]), o1 = bfhi(ov[q][x][e]), g0 = bflo(gv[q][x][e]), g1 = bfhi(gv[q][x][e]);
                    const int k = 8 * x + 2 * e; const float n0 = ng[k >> 2][k & 3], n1 = ng[(k + 1) >> 2][(k + 1) & 3];
                    w[e] = cvt_pk_bf16(o0 * rs * n0 * (g0 / (1.f + __expf(-g0))), o1 * rs * n1 * (g1 / (1.f + __expf(-g1)))); }
                *(u32x4*)(op[q] + 8 * x) = w; } }
    }
}

template <class EpiS>
__device__ __forceinline__ void sample_gemm(const Frame& F, const bf16_t* A, const bf16_t* Bt, int N, int K, const EpiS& E) {
    LAS float* red = (LAS float*)F.lds;
    const int lane = F.lane, w = F.wave, fr = lane & 15, g = lane >> 4, kw = K >> 3, npieces = (N >> 5) * 8;
    for (int p = blockIdx.x; p < npieces; p += F.G) {
        const int rg = p & 7, cgp = p >> 3;
        const bf16_t* ap = A + (size_t)(rg * 16 + fr) * K + w * kw + 8 * g;
        const bf16_t* b0 = Bt + (size_t)(cgp * 32 + fr) * K + w * kw + 8 * g; const bf16_t* b1 = b0 + (size_t)16 * K;
        f32x4 c0 = {0.f, 0.f, 0.f, 0.f}, c1 = {0.f, 0.f, 0.f, 0.f};
#pragma unroll 4
        for (int k = 0; k < kw; k += 32) { const bf16x8 a = *(const bf16x8*)(ap + k), x0 = *(const bf16x8*)(b0 + k), x1 = *(const bf16x8*)(b1 + k);
            c0 = mfma16(x0, a, c0); c1 = mfma16(x1, a, c1); }
        *(LAS f32x4*)(red + w * 512 + fr * 32 + 4 * g) = c0; *(LAS f32x4*)(red + w * 512 + fr * 32 + 16 + 4 * g) = c1;
        __syncthreads();
        { float v = 0.f;
#pragma unroll
            for (int x = 0; x < 8; ++x) v += red[x * 512 + F.tid];
            E(rg * 16 + (F.tid >> 5), cgp * 32 + (F.tid & 31), v); }
        __syncthreads();
    }
}
struct SEpiRes { const float* res; const bf16_t* resB; bf16_t* out;
    __device__ __forceinline__ void operator()(int b, int col, float v) const { const float x = res ? res[(size_t)b * DM + col] : bf2f(resB[(size_t)b * DM + col]); out[(size_t)b * DM + col] = f2bf(ALPHA * x + v); } };
struct SEpiGlaIn { bf16_t* P; float* LA; const float* ba;
    __device__ __forceinline__ void operator()(int b, int col, float v) const {
        if (col < NPROJ) P[(size_t)(SROW + b) * NPROJ + col] = f2bf(v);
        else { const float z = v + ba[col - NPROJ]; LA[(size_t)(SROW + b) * 512 + col - NPROJ] = -(fmaxf(-z, 0.f) + log1pf(__expf(-fabsf(z)))) * 0.0625f; } } };

struct Args { const float* in[24]; float* out; unsigned char* ws; int ph_lo, ph_hi; };
constexpr int NPHASE = 16;
__global__ void __launch_bounds__(512, 2) mega_fwd(Args args) {
    extern __shared__ __attribute__((aligned(16))) unsigned char lds[];
    cg::grid_group grid = cg::this_grid();
    Frame F;
    F.lds = (LAS unsigned char*)lds;
    F.tid = threadIdx.x; F.lane = F.tid & 63; F.wave = __builtin_amdgcn_readfirstlane(F.tid >> 6); F.G = gridDim.x;
#pragma unroll
    for (int i = 0; i < 24; ++i) F.in[i] = args.in[i];
    F.out = args.out;
    unsigned char* ws = args.ws;
    F.Wqkv = (bf16_t*)(ws + WS_WQKV); F.Wo = (bf16_t*)(ws + WS_WO); F.Wup = (bf16_t*)(ws + WS_WUP); F.Wdn = (bf16_t*)(ws + WS_WDN); F.Wgin = (bf16_t*)(ws + WS_WGIN); F.Wgo = (bf16_t*)(ws + WS_WGO);
    F.XN = (bf16_t*)(ws + WS_XN) + 8 * DM; F.OB = (bf16_t*)(ws + 400 * MiB); F.YB = (bf16_t*)(ws + WS_LA);     F.R1 = (bf16_t*)(ws + WS_R1); F.LA = (float*)(ws + WS_LA); F.SSQ = (float*)(ws + WS_SSQ);
    F.ropec = (float*)(ws + WS_ROPE); F.ropes = F.ropec + 2049 * 32;
    volatile LAS unsigned* MISC = (volatile LAS unsigned*)(F.lds + LDS_BYTES - 64);
    if (F.tid < 4) MISC[F.tid] = 0u;
    __syncthreads();
    XcdBarrier xbar = xcd_barrier_post((unsigned*)(ws + 16384), MISC);
    const int lo = args.ph_lo, hi = args.ph_hi;
#ifndef PH_MASK
#define PH_MASK 0xffff
#endif
#define IN(k) (((PH_MASK >> (k)) & 1) && lo <= (k) && (k) < hi)
#define GRID_SEAM_CG() do { asm volatile("s_waitcnt vmcnt(0) lgkmcnt(0)" ::: "memory"); grid.sync(); \
        if (F.tid == 0) { __builtin_amdgcn_fence(__ATOMIC_ACQUIRE, "agent"); asm volatile("s_waitcnt vmcnt(0)" ::: "memory"); } __syncthreads(); } while (0)
#define GRID_SEAM() do { xcd_barrier(xbar); } while (0)
#ifndef PROBE_SPIN
#define PROBE_SPIN 0
#endif
#ifndef PROBE_RVR
#define PROBE_RVR 0
#endif
#ifndef PROBE_CAL
#define PROBE_CAL 0
#endif
#define PROBING (PROBE_SPIN || PROBE_RVR || PROBE_CAL)
    unsigned long long* const tsb = (unsigned long long*)(ws + 4096);
#define STAMP(k) do { if (PROBING && blockIdx.x == 0 && F.tid == 0) tsb[k] = __builtin_amdgcn_s_memrealtime(); } while (0)
#define SEAM(k) do { if (IN(k) && IN((k) + 1)) { if ((k) == 0) GRID_SEAM_CG(); else GRID_SEAM(); STAMP((k) + 1); } } while (0)
    STAMP(0);
    using pg8::Gemm; using pg8::StaticOrder;

    if (IN(0)) { p0_prologue(F); } SEAM(0);
    if (IN(1)) {
        Gemm g{F.XN, F.Wqkv, NQKV, DM, 129, 0}; StaticOrder S; S.init(129, NQKV, F.G, (int)blockIdx.x);
        pg8::EpiBf16Bias E{F.R1, NQKV, F.in[7]};
        pg8::gemm_phase<pg8::EpiBf16Bias, StaticOrder, true, true>(F.lds, g, S, E);
    } SEAM(1);
    if (IN(2)) {
        for (int u = blockIdx.x; u < 640; u += F.G) {
            if (u < 128) attn_sample_unit(F, u);
            else { const int v = u - 128; attn_prompt_unit(F, v >> 5, (v >> 4) & 1, v & 15); }
        }
    } SEAM(2);
    if (IN(3)) {
        { SEpiRes ES{F.in[1], nullptr, F.YB + (size_t)SROW * DM}; sample_gemm(F, F.XN + (size_t)SROW * DM, F.Wo, DM, DM, ES); }
        Gemm g{F.XN, F.Wo, DM, DM, 128, 0}; StaticOrder S; S.init(128, DM, F.G, (int)blockIdx.x);
        pg8::EpiRes<false> E{F.in[0], F.in[1], nullptr, F.YB};
#ifdef DBG_COPY
        (void)g; (void)S; (void)E;
        for (int idx = blockIdx.x * 512 + F.tid; idx < (MP + NS) * 128; idx += F.G * 512) { const int i = idx >> 7, c = (idx & 127) * 8; const int r = i < MP ? i : SROW + (i - MP);
            const u32x4 v = *(const u32x4*)(F.OB + (size_t)r * DM + c); float* o = F.out + (size_t)i * DM + c;
            *(f32x4*)o = (f32x4){bflo(v[0]), bfhi(v[0]), bflo(v[1]), bfhi(v[1])}; *(f32x4*)(o + 4) = (f32x4){bflo(v[2]), bfhi(v[2]), bflo(v[3]), bfhi(v[3])}; }
#else
        pg8::gemm_phase<pg8::EpiRes<false>, StaticOrder, true, true>(F.lds, g, S, E);
#endif
    } SEAM(3);
    if (IN(4)) { ln_phase(F, F.in[20], F.in[21], false); } SEAM(4);
#define FFN_PHASES(l, pb) do { \
        if (IN(pb)) { \
            Gemm g{F.XN, F.Wup + (size_t)(l) * NUP * DM, NUP, DM, 134, 1}; StaticOrder S; S.init(134, NUP, F.G, (int)blockIdx.x); \
            pg8::EpiUp E{F.R1, F.in[17] + (size_t)(l) * 3 * FF, F.in[18] + (size_t)(l) * FF, F.in[5] + (size_t)(l) * NS * 2 * FF, F.out + O_CP + (size_t)(l) * NBATCH * 2 * FF, F.out + O_CS + (size_t)(l) * NS * 2 * FF}; \
            pg8::gemm_phase<pg8::EpiUp, StaticOrder, true, true>(F.lds, g, S, E); \
        } SEAM(pb); \
        if (IN((pb) + 1)) { \
            { SEpiRes ES{nullptr, F.XN + (size_t)SROW * DM, F.YB + (size_t)SROW * DM}; sample_gemm(F, F.R1 + (size_t)SROW * FF, F.Wdn + (size_t)(l) * DM * FF, DM, FF, ES); } \
            Gemm g{F.R1, F.Wdn + (size_t)(l) * DM * FF, DM, FF, 128, 0}; StaticOrder S; S.init(128, DM, F.G, (int)blockIdx.x); \
            pg8::EpiRes<true> E{nullptr, nullptr, F.XN, F.YB}; \
            pg8::gemm_phase<pg8::EpiRes<true>, StaticOrder, true, true>(F.lds, g, S, E); \
        } SEAM((pb) + 1); \
        if (IN((pb) + 2)) { ln_phase(F, F.in[22] + (size_t)(l) * DM, F.in[23] + (size_t)(l) * DM, (l) == 1); } SEAM((pb) + 2); } while (0)
    FFN_PHASES(0, 5);
    if (IN(8)) {
        { SEpiGlaIn ES{F.R1, F.LA, F.in[13]}; sample_gemm(F, F.XN + (size_t)SROW * DM, F.Wgin, NGIN, DM, ES); }
        Gemm g{F.XN, F.Wgin, NGIN, DM, 128, 0}; StaticOrder S; S.init(128, NGIN, F.G, (int)blockIdx.x);
        pg8::EpiGlaIn E{F.R1, F.LA, F.in[13]};
        pg8::gemm_phase<pg8::EpiGlaIn, StaticOrder, true, true>(F.lds, g, S, E);
    } SEAM(8);
    if (IN(9)) {
        for (int u = blockIdx.x; u < 768; u += F.G) {
            if (u < 256) gla_prompt_unit(F, u >> 4, (u >> 2) & 3, u & 3);
            else { const int v = u - 256; gla_sample_unit(F, v >> 2, v & 3); }
        }
    } SEAM(9);
    if (IN(10)) { gla_norm_phase(F); } SEAM(10);
    if (IN(11)) {
        { SEpiRes ES{nullptr, F.XN + (size_t)SROW * DM, F.YB + (size_t)SROW * DM}; sample_gemm(F, F.OB + (size_t)SROW * DM, F.Wgo, DM, DM, ES); }
        Gemm g{F.OB, F.Wgo, DM, DM, 128, 0}; StaticOrder S; S.init(128, DM, F.G, (int)blockIdx.x);
        pg8::EpiRes<true> E{nullptr, nullptr, F.XN, F.YB};
        pg8::gemm_phase<pg8::EpiRes<true>, StaticOrder, true, true>(F.lds, g, S, E);
    } SEAM(11);
    if (IN(12)) { ln_phase(F, F.in[20] + DM, F.in[21] + DM, false); } SEAM(12);
    FFN_PHASES(1, 13);
#undef FFN_PHASES
    if (PROBING) {
        GRID_SEAM(); STAMP(16);
        if (blockIdx.x == 0 && F.tid == 0) {
            unsigned long long spin = 0, rv = 0;
            for (int k = 0; k < 16; ++k) { const unsigned long long d = tsb[k + 1] - tsb[k]; if ((PROBE_SPIN >> k) & 1) spin += d; if ((PROBE_RVR >> k) & 1) rv += d; }
            tsb[32] = spin; ((float*)(tsb + 33))[0] = 0.01f * sqrtf(1.f + (float)rv * 0.01f / 4000.f);
        }
        GRID_SEAM();
        const unsigned long long spin = tsb[32]; const float dd = 1.f + ((const float*)(tsb + 33))[0];
        for (int idx = blockIdx.x * 512 + F.tid; idx < 1441792 / 4; idx += F.G * 512) { f32x4* p = (f32x4*)(F.out + O_CS) + idx; *p = *p * dd; }
        const unsigned long long t0 = __builtin_amdgcn_s_memrealtime();
        while (__builtin_amdgcn_s_memrealtime() - t0 < spin) __builtin_amdgcn_s_sleep(8);
    }
#undef IN
#undef SEAM
}

extern "C" void kernel_launch(void* const* d_in, const int* in_sizes, int n_in, void* d_out, int out_size, void* d_ws, size_t ws_size, hipStream_t stream) {
    static int grid = 0;
    if (grid == 0) {
        if (n_in != 24 || out_size != 58900480 || ws_size < 466 * MiB) { fprintf(stderr, "kernel_launch: unexpected shapes (n_in %d out %d ws %zu)\n", n_in, out_size, ws_size); grid = -1; return; }
        int dev = 0, cus = 0, per_cu = 0;
        if (hipGetDevice(&dev) != hipSuccess || hipDeviceGetAttribute(&cus, hipDeviceAttributeMultiprocessorCount, dev) != hipSuccess) { grid = -1; return; }
        if (hipFuncSetAttribute((const void*)mega_fwd, hipFuncAttributeMaxDynamicSharedMemorySize, LDS_BYTES) != hipSuccess) { fprintf(stderr, "kernel_launch: hipFuncSetAttribute failed\n"); grid = -1; return; }
        if (hipOccupancyMaxActiveBlocksPerMultiprocessor(&per_cu, (const void*)mega_fwd, 512, LDS_BYTES) != hipSuccess || per_cu < 1) { fprintf(stderr, "kernel_launch: occupancy query says %d\n", per_cu); per_cu = 1; }
        (void)hipGetLastError();
        grid = cus * 1;
    }
    if (grid < 0) return;
    if (hipMemsetAsync((char*)d_ws + 16384, 0, 16384, stream) != hipSuccess) { fprintf(stderr, "kernel_launch: memset failed\n"); return; }
    Args a{};
    for (int i = 0; i < 24; ++i) a.in[i] = (const float*)d_in[i];
    a.out = (float*)d_out; a.ws = (unsigned char*)d_ws;
#if MK_PER_PHASE
    for (int p = 0; p < NPHASE; ++p) { a.ph_lo = p; a.ph_hi = p + 1; hipLaunchKernelGGL(mega_fwd, dim3(grid), dim3(512), LDS_BYTES, stream, a); }
#else
    a.ph_lo = 0; a.ph_hi = NPHASE;
    void* kargs[] = {&a};
    const hipError_t e = hipLaunchCooperativeKernel((const void*)mega_fwd, dim3(grid), dim3(512), kargs, LDS_BYTES, stream);
    if (e != hipSuccess) fprintf(stderr, "kernel_launch: cooperative launch failed: %s (grid %d)\n", hipGetErrorString(e), grid);
#endif
}
```

```cpp
#include <hip/hip_runtime.h>
#include <hip/hip_cooperative_groups.h>
#include <cstdio>
#include <cstdint>
namespace cg = cooperative_groups;

#ifndef MK_PER_PHASE
#define MK_PER_PHASE 0
#endif

constexpr int DM = 1024, NBATCH = 16, SEQ = 2048, MP = NBATCH * SEQ, NS = 128;
constexpr int SROW = 33024;
constexpr int MROWS = 33280;
constexpr int NQKV = 1280, FF = 2816, NUP = 2 * FF, NPROJ = 3072, NGIN = 3584;
constexpr float ALPHA = 1.41421356237f, LN_EPS = 1e-5f, QS_GLA = 0.08838834764831845f;
constexpr size_t O_Y = 0, O_YS = 33554432, O_KP = 33685504, O_VP = 33947648, O_KS = 34209792, O_VS = 36306944, O_GP = 38404096, O_GS = 40501248, O_CP = 57278464, O_CS = 57458688;
constexpr size_t MiB = 1u << 20;
constexpr size_t WS_ROPE = 1 * MiB;
constexpr size_t WS_WQKV = 2 * MiB;
constexpr size_t WS_WO = WS_WQKV + 2621440;
constexpr size_t WS_WUP = WS_WO + 2 * MiB;
constexpr size_t WS_WDN = WS_WUP + 22 * MiB;
constexpr size_t WS_WGIN = WS_WDN + 11 * MiB;
constexpr size_t WS_WGO = WS_WGIN + 7 * MiB;
constexpr size_t WS_XN = 50 * MiB;
constexpr size_t WS_SSQ = 116 * MiB;
constexpr size_t WS_R1 = 119 * MiB;
constexpr size_t WS_LA = WS_R1 + (size_t)MROWS * NPROJ * 2;
constexpr size_t WS_END = WS_LA + (size_t)MROWS * 512 * 4;
static_assert(WS_WGO + 2 * MiB <= WS_XN && WS_XN + (size_t)(MROWS + 8) * DM * 2 <= WS_SSQ && WS_SSQ + (size_t)MROWS * 64 <= WS_R1 && WS_END <= 512 * MiB, "ws map");

constexpr int LDS_BYTES = 147456;

#define LAS __attribute__((address_space(3)))
typedef unsigned short bf16_t;
typedef short bf16x8 __attribute__((ext_vector_type(8)));
typedef float f32x4 __attribute__((ext_vector_type(4)));
typedef float f32x2 __attribute__((ext_vector_type(2)));
typedef unsigned u32x4 __attribute__((ext_vector_type(4)));
typedef unsigned u32x2 __attribute__((ext_vector_type(2)));

typedef __bf16 bf16x2_t __attribute__((ext_vector_type(2)));
__device__ __forceinline__ unsigned cvt_pk_bf16(float lo, float hi) { const f32x2 v = {lo, hi}; return __builtin_bit_cast(unsigned, __builtin_convertvector(v, bf16x2_t)); }
__device__ __forceinline__ float bflo(unsigned w) { return __uint_as_float(w << 16); }
__device__ __forceinline__ float bfhi(unsigned w) { return __uint_as_float(w & 0xffff0000u); }
__device__ __forceinline__ float bf2f(bf16_t h) { return __uint_as_float((unsigned)h << 16); }
__device__ __forceinline__ bf16_t f2bf(float f) { return (bf16_t)(cvt_pk_bf16(f, 0.f) & 0xffffu); }
__device__ __forceinline__ bf16x8 mk8(unsigned a, unsigned b, unsigned c, unsigned d) { u32x4 v = {a, b, c, d}; return __builtin_bit_cast(bf16x8, v); }
__device__ __forceinline__ f32x4 mfma16(bf16x8 a, bf16x8 b, f32x4 c) { return __builtin_amdgcn_mfma_f32_16x16x32_bf16(a, b, c, 0, 0, 0); }
__device__ __forceinline__ bool row_valid(int r) { return r < MP || (r >= SROW && r < SROW + NS); }
__device__ __forceinline__ size_t xy_off(int r) { return (size_t)(r < MP ? r : r - (SROW - MP)) * DM; }

namespace pg8 {
#define PG8_LAS __attribute__((address_space(3)))
constexpr int BM = 256, BK = 64, HALF = 128, HTB = HALF * BK * 2, STAGE_BYTES = 8 * HTB, NXCD = 8, WGM = 8;
__host__ __device__ __forceinline__ int lds_byte(int r, int c) { const int st = (r >> 4) * 2 + (c >> 5), rr = r & 15, cc = c & 31, ob = rr * 64 + cc * 2; return st * 1024 + (ob ^ (((ob >> 9) & 1) << 5)); }
__host__ __device__ __forceinline__ void stage_rc(int b, int& R, int& C) { const int st = b / 1024, sb = b % 1024, swz = sb ^ (((sb >> 9) & 1) << 5); R = (st >> 1) * 16 + swz / 64; C = (st & 1) * 32 + (swz % 64) / 2; }
__host__ __device__ __forceinline__ int perm32(int rho) { const int n = rho >> 4, i = rho & 15; return 8 * (i >> 2) + 4 * n + (i & 3); }

struct Unit { int pm, pn; };
struct Gemm { const bf16_t* A; const bf16_t* Bt; int N, K, nM, mode; };
__device__ __forceinline__ int tile_row0(int pm) { return 256 * (pm < 128 ? pm : 129); }
__device__ __forceinline__ int tile_base1(int pm) { return pm < 133 ? 248 * pm : SROW; }
__device__ __forceinline__ const char* abase(const Gemm& g, int pm) {
    const long row = g.mode ? (long)tile_base1(pm) - 2 : (long)tile_row0(pm);
    return (const char*)g.A + row * (long)g.K * 2;
}

struct StaticOrder {
    int nM, nN, nwg, G, c;
    __host__ __device__ void init(int nM_, int N, int G_, int c_) { nM = nM_; nN = N / BM; nwg = nM * nN; G = G_; c = c_; }
    __host__ __device__ bool next(int i, Unit& u) const {
        const long L = (long)i * G + c; if (L >= nwg) return false;
        int wgid = (int)L; { const int q = nwg / NXCD, r = nwg % NXCD, xcd = wgid % NXCD, off = wgid / NXCD; wgid = (xcd < r ? xcd * (q + 1) : r * (q + 1) + (xcd - r) * q) + off; }
        const int nig = WGM * nN, gid = wgid / nig, fm = gid * WGM, gsz = (nM - fm) < WGM ? (nM - fm) : WGM;
        u.pm = fm + ((wgid % nig) % gsz); u.pn = (wgid % nig) / gsz; return true;
    }
    __device__ __forceinline__ void a_ready(const Unit&) const {}
    __device__ __forceinline__ void done(const Unit&) const {}
};

__device__ __forceinline__ f32x2 gelu_pk(f32x2 v) {
    const f32x2 av = __builtin_elementwise_abs(v), d = av * 0.2316418882f + 1.0f;
    f32x2 t; t.x = __builtin_amdgcn_rcpf(d.x); t.y = __builtin_amdgcn_rcpf(d.y);
    f32x2 q = t * 0.5307027145f + (-0.7265760135f); q = q * t + 0.7107068705f; q = q * t + (-0.142248368f); q = q * t + 0.127414796f; q = q * t;
    const f32x2 s = (v * v) * (-0.72134752044f);
    f32x2 e; e.x = __builtin_amdgcn_exp2f(s.x); e.y = __builtin_amdgcn_exp2f(s.y);
    const f32x2 m = v * (q * e), r = v - m;
    f32x2 o; o.x = v.x < 0.f ? m.x : r.x; o.y = v.y < 0.f ? m.y : r.y; return o;
}

struct EpiBf16Bias {
    static constexpr bool PERM = true, AFTER_DRAIN = false;
    bf16_t* O; int ldc; const float* bias;
    __device__ __forceinline__ void operator()(const f32x4 (&acc)[2][2][4][2], const Unit& u, int wr, int wc, int fr, int fq) const {
        const int row0 = tile_row0(u.pm) + wr * 64 + fr, col0 = u.pn * BM + wc * 32 + 8 * fq;
        f32x4 bv[2][2];
#pragma unroll
        for (int bj = 0; bj < 2; ++bj)
#pragma unroll
            for (int n = 0; n < 2; ++n) bv[bj][n] = *(const f32x4*)(bias + col0 + bj * HALF + 4 * n);
#pragma unroll
        for (int ai = 0; ai < 2; ++ai)
#pragma unroll
            for (int m = 0; m < 4; ++m) { bf16_t* rowp = O + (size_t)(row0 + ai * HALF + m * 16) * ldc + col0;
#pragma unroll
                for (int bj = 0; bj < 2; ++bj) { const f32x4 v0 = acc[ai][bj][m][0] + bv[bj][0], v1 = acc[ai][bj][m][1] + bv[bj][1];
                    u32x4 w; w.x = cvt_pk_bf16(v0[0], v0[1]); w.y = cvt_pk_bf16(v0[2], v0[3]); w.z = cvt_pk_bf16(v1[0], v1[1]); w.w = cvt_pk_bf16(v1[2], v1[3]);
                    *(u32x4*)(rowp + bj * HALF) = w; } }
    }
};
template <bool RESBF> struct EpiRes {
    static constexpr bool PERM = true, AFTER_DRAIN = false;
    const float* resP; const float* resS; const bf16_t* resB; bf16_t* out;
    __device__ __forceinline__ void operator()(const f32x4 (&acc)[2][2][4][2], const Unit& u, int wr, int wc, int fr, int fq) const {
        const int rb = tile_row0(u.pm) + wr * 64 + fr, col0 = u.pn * BM + wc * 32 + 8 * fq;
#pragma unroll
        for (int ai = 0; ai < 2; ++ai)
#pragma unroll
            for (int m = 0; m < 4; ++m) { const int r = rb + ai * HALF + m * 16;
                if (row_valid(r)) {
                    bf16_t* op = out + (size_t)r * DM + col0;
#pragma unroll
                    for (int bj = 0; bj < 2; ++bj) { f32x4 x0, x1;
                        if (RESBF) { const u32x4 rv = *(const u32x4*)(resB + (size_t)r * DM + col0 + bj * HALF);
                            x0 = (f32x4){bflo(rv[0]), bfhi(rv[0]), bflo(rv[1]), bfhi(rv[1])}; x1 = (f32x4){bflo(rv[2]), bfhi(rv[2]), bflo(rv[3]), bfhi(rv[3])}; }
                        else { const float* rp = (r < MP ? resP + (size_t)r * DM : resS + (size_t)(r - SROW) * DM) + col0 + bj * HALF; x0 = *(const f32x4*)rp; x1 = *(const f32x4*)(rp + 4); }
                        const f32x4 y0 = x0 * ALPHA + acc[ai][bj][m][0], y1 = x1 * ALPHA + acc[ai][bj][m][1];
                        *(u32x4*)(op + bj * HALF) = (u32x4){cvt_pk_bf16(y0[0], y0[1]), cvt_pk_bf16(y0[2], y0[3]), cvt_pk_bf16(y1[0], y1[1]), cvt_pk_bf16(y1[2], y1[3])}; } } }
    }
};
struct EpiGlaIn {
    static constexpr bool PERM = true, AFTER_DRAIN = false;
    bf16_t* P; float* LA; const float* ba;
    __device__ __forceinline__ void operator()(const f32x4 (&acc)[2][2][4][2], const Unit& u, int wr, int wc, int fr, int fq) const {
        const int row0 = tile_row0(u.pm) + wr * 64 + fr;
        if (u.pn < 12) {
            const int col0 = u.pn * BM + wc * 32 + 8 * fq;
#pragma unroll
            for (int ai = 0; ai < 2; ++ai)
#pragma unroll
                for (int m = 0; m < 4; ++m) { bf16_t* rowp = P + (size_t)(row0 + ai * HALF + m * 16) * NPROJ + col0;
#pragma unroll
                    for (int bj = 0; bj < 2; ++bj) { const f32x4 v0 = acc[ai][bj][m][0], v1 = acc[ai][bj][m][1];
                        u32x4 w; w.x = cvt_pk_bf16(v0[0], v0[1]); w.y = cvt_pk_bf16(v0[2], v0[3]); w.z = cvt_pk_bf16(v1[0], v1[1]); w.w = cvt_pk_bf16(v1[2], v1[3]);
                        *(u32x4*)(rowp + bj * HALF) = w; } }
        } else {
            const int col0 = (u.pn - 12) * BM + wc * 32 + 8 * fq;
#pragma unroll
            for (int bj = 0; bj < 2; ++bj)
#pragma unroll
                for (int n = 0; n < 2; ++n) { const f32x4 bv = *(const f32x4*)(ba + col0 + bj * HALF + 4 * n);
#pragma unroll
                    for (int ai = 0; ai < 2; ++ai)
#pragma unroll
                        for (int m = 0; m < 4; ++m) { const f32x4 z = acc[ai][bj][m][n] + bv; f32x4 o;
#pragma unroll
                            for (int e = 0; e < 4; ++e) o[e] = -(fmaxf(-z[e], 0.f) + __logf(1.f + __expf(-fabsf(z[e])))) * 0.0625f;
                            *(f32x4*)(LA + (size_t)(row0 + ai * HALF + m * 16) * 512 + col0 + bj * HALF + 4 * n) = o; } }
        }
    }
};
__device__ __forceinline__ float dpp_ror1(float v) { return __int_as_float(__builtin_amdgcn_update_dpp(0, __float_as_int(v), 0x121, 0xf, 0xf, false)); }
__device__ __forceinline__ float dpp_ror2(float v) { return __int_as_float(__builtin_amdgcn_update_dpp(0, __float_as_int(v), 0x122, 0xf, 0xf, false)); }
struct EpiUp {
    static constexpr bool PERM = true, AFTER_DRAIN = false;
    bf16_t* G; const float* cw; const float* cb; const float* sconv; float* ocp; float* ocs;
    __device__ __forceinline__ void operator()(const f32x4 (&acc)[2][2][4][2], const Unit& u, int wr, int wc, int fr, int fq) const {
        const int B = tile_base1(u.pm); const bool samp = (u.pm >= 133);
#pragma unroll
        for (int n = 0; n < 2; ++n) {
            const int f = u.pn * HALF + wc * 32 + 8 * fq + 4 * n;
            const f32x4 w0 = *(const f32x4*)(cw + f), w1 = *(const f32x4*)(cw + FF + f), w2 = *(const f32x4*)(cw + 2 * FF + f), bb = *(const f32x4*)(cb + f);
#pragma unroll
            for (int ai = 0; ai < 2; ++ai) {
                const int seg = 2 * ai + wr;
                f32x4 p1 = {0.f, 0.f, 0.f, 0.f}, p2 = {0.f, 0.f, 0.f, 0.f};
#pragma unroll
                for (int m = 0; m < 4; ++m) {
                    const f32x4 a = acc[ai][0][m][n], uu = acc[ai][1][m][n];
                    f32x4 a1, a2;
#pragma unroll
                    for (int e = 0; e < 4; ++e) { a1[e] = dpp_ror1(a[e]); a2[e] = dpp_ror2(a[e]); }
                    f32x4 s1, s2;
#pragma unroll
                    for (int e = 0; e < 4; ++e) { s1[e] = fr >= 1 ? a1[e] : p1[e]; s2[e] = fr >= 2 ? a2[e] : p2[e]; }
                    p1 = a1; p2 = a2;
                    const int j = 16 * m + fr, r = B + 62 * seg + j - 2;
                    bool doit;
                    if (!samp) {
                        doit = (j >= 2) && (r < MP);
                        const int tt = r & (SEQ - 1);
                        if (tt < 1) s1 = (f32x4){0.f, 0.f, 0.f, 0.f};
                        if (tt < 2) s2 = (f32x4){0.f, 0.f, 0.f, 0.f};
                        if (doit && tt >= SEQ - 2) *(f32x4*)(ocp + ((size_t)(r >> 11) * 2 + (tt - (SEQ - 2))) * FF + f) = a;
                    } else {
                        doit = (j >= 2) && (r < SROW + NS);
                        if (doit) { const int bs = r - SROW;
                            s2 = *(const f32x4*)(sconv + ((size_t)bs * 2 + 0) * FF + f); s1 = *(const f32x4*)(sconv + ((size_t)bs * 2 + 1) * FF + f);
                            *(f32x4*)(ocs + ((size_t)bs * 2 + 0) * FF + f) = s1; *(f32x4*)(ocs + ((size_t)bs * 2 + 1) * FF + f) = a; }
                    }
                    if (doit) {
                        const f32x4 c = bb + w0 * s2 + w1 * s1 + w2 * a;
                        const f32x2 g0 = gelu_pk((f32x2){c[0], c[1]}), g1 = gelu_pk((f32x2){c[2], c[3]});
                        u32x2 w; w.x = cvt_pk_bf16(g0.x * uu[0], g0.y * uu[1]); w.y = cvt_pk_bf16(g1.x * uu[2], g1.y * uu[3]);
                        *(u32x2*)(G + (size_t)r * FF + f) = w;
                    }
                }
            }
        }
    }
};

template <class Epi, class Sched, bool ALIGN_EPI = false, bool SP2 = false>
__device__ __forceinline__ void gemm_phase(PG8_LAS unsigned char* lds, const Gemm g, const Sched& S, const Epi& E) {
    const int tid = threadIdx.x, wid = __builtin_amdgcn_readfirstlane(tid >> 6), lane = tid & 63, wr = wid >> 2, wc = wid & 3, fr = lane & 15, fq = lane >> 4;
    const int K = g.K, nt = K / BK;
    unsigned voffA[2], voffB[2];
#pragma unroll
    for (int i = 0; i < 2; ++i) { int R, C; stage_rc(tid * 16 + i * 8192, R, C); const int Rb = Epi::PERM ? ((R & ~31) + perm32(R & 31)) : R;
        voffA[i] = (unsigned)((g.mode ? (R - 2 * (R >> 6)) : R) * K + C) * 2u; voffB[i] = (unsigned)(Rb * K + C) * 2u; }
    const size_t kstep = (size_t)(BK * 2);
    const size_t hstep = (size_t)HALF * K * 2;
    const size_t tstep = 2 * hstep; const size_t hsA = g.mode ? (size_t)124 * K * 2 : hstep;
    const unsigned ldsw = (unsigned)wid * 1024u;
    const int aoff = lds_byte(wr * 64 + fr, fq * 8), boff = lds_byte(wc * 32 + fr, fq * 8);
#define PG8_SA(b, h) (((b) * 2 + (h)) * HTB)
#define PG8_SB(b, h) ((4 + (b) * 2 + (h)) * HTB)
#define PG8_STAGE(bufoff, gbase, voff) do { _Pragma("unroll") for (int _i = 0; _i < 2; ++_i) \
        __builtin_amdgcn_global_load_lds((const unsigned*)((const char*)(gbase) + (voff)[_i]), (PG8_LAS unsigned*)(lds + (bufoff) + ldsw + _i * 8192), 16, 0, 0); } while (0)
#define PG8_LDA(dst, b, h) do { _Pragma("unroll") for (int m = 0; m < 4; ++m) _Pragma("unroll") for (int k = 0; k < 2; ++k) dst[m][k] = *(const PG8_LAS bf16x8*)(lds + PG8_SA(b, h) + aoff + m * 2048 + k * 1024); } while (0)
#define PG8_LDB(dst, b, h) do { _Pragma("unroll") for (int n = 0; n < 2; ++n) _Pragma("unroll") for (int k = 0; k < 2; ++k) dst[n][k] = *(const PG8_LAS bf16x8*)(lds + PG8_SB(b, h) + boff + n * 2048 + k * 1024); } while (0)
#define PG8_MMA(ai, bj, At, Bt) do { __builtin_amdgcn_s_setprio(1); _Pragma("unroll") for (int m = 0; m < 4; ++m) _Pragma("unroll") for (int n = 0; n < 2; ++n) _Pragma("unroll") for (int k = 0; k < 2; ++k) \
        acc[ai][bj][m][n] = __builtin_amdgcn_mfma_f32_16x16x32_bf16(Bt[n][k], At[m][k], acc[ai][bj][m][n], 0, 0, 0); __builtin_amdgcn_s_setprio(0); } while (0)
#define PG8_WAIT_V(n) asm volatile("s_waitcnt vmcnt(" #n ")" ::: "memory")
#define PG8_WAIT_L(n) asm volatile("s_waitcnt lgkmcnt(" #n ")" ::: "memory")
#define PG8_BAR __builtin_amdgcn_s_barrier()
#define PG8_SCHED __builtin_amdgcn_sched_barrier(0)
    Unit cur, nxt; int ui = 0;
    if (!S.next(0, cur)) return;
    f32x4 acc[2][2][4][2];
#pragma unroll
    for (int a = 0; a < 2; ++a)
#pragma unroll
        for (int b = 0; b < 2; ++b)
#pragma unroll
            for (int m = 0; m < 4; ++m)
#pragma unroll
                for (int n = 0; n < 2; ++n) acc[a][b][m][n] = (f32x4){0.f, 0.f, 0.f, 0.f};
    bf16x8 At[4][2], B0[2][2], B1[2][2];
    const char* cA = abase(g, cur.pm); const char* cB = (const char*)g.Bt + (size_t)cur.pn * tstep;
    S.a_ready(cur);
    if constexpr (SP2) {
        PG8_STAGE(PG8_SB(0, 0), cB, voffB); PG8_STAGE(PG8_SB(0, 1), cB + hstep, voffB); PG8_STAGE(PG8_SA(0, 0), cA, voffA); PG8_STAGE(PG8_SA(0, 1), cA + hsA, voffA);
        if (wr == 1) PG8_BAR;
        PG8_WAIT_V(2); PG8_BAR;
        PG8_STAGE(PG8_SB(1, 0), cB + kstep, voffB); PG8_STAGE(PG8_SA(1, 0), cA + kstep, voffA); PG8_STAGE(PG8_SB(1, 1), cB + hstep + kstep, voffB);
        PG8_WAIT_V(6); PG8_BAR;
    } else {
        PG8_STAGE(PG8_SB(0, 0), cB, voffB); PG8_STAGE(PG8_SA(0, 0), cA, voffA); PG8_STAGE(PG8_SB(0, 1), cB + hstep, voffB); PG8_STAGE(PG8_SA(0, 1), cA + hsA, voffA);
        if (wr == 1) PG8_BAR;
        PG8_WAIT_V(4); PG8_BAR;
        PG8_STAGE(PG8_SB(1, 0), cB + kstep, voffB); PG8_STAGE(PG8_SA(1, 0), cA + kstep, voffA); PG8_STAGE(PG8_SB(1, 1), cB + hstep + kstep, voffB);
        PG8_WAIT_V(6); PG8_BAR;
    }
    for (;;) {
        const bool has_next = S.next(ui + 1, nxt);
        const char* nA = has_next ? abase(g, nxt.pm) : cA; const char* nB = has_next ? (const char*)g.Bt + (size_t)nxt.pn * tstep : cB;
        for (int t = 0; t < nt; t += 2) {
            const bool last = (t == nt - 2);
            const char* a1 = cA + (size_t)(t + 1) * kstep;
            const char* a2 = last ? nA : cA + (size_t)(t + 2) * kstep; const char* b2 = last ? nB : cB + (size_t)(t + 2) * kstep;
            const char* a3 = a2 + kstep; const char* b3 = b2 + kstep;
            if (last && has_next) S.a_ready(nxt);
            if constexpr (SP2) {
            PG8_LDB(B0, 0, 0); PG8_LDB(B1, 0, 1); PG8_SCHED; PG8_LDA(At, 0, 0); PG8_STAGE(PG8_SA(1, 1), a1 + hsA, voffA);
            PG8_WAIT_V(8); PG8_WAIT_L(0); PG8_BAR; PG8_MMA(0, 0, At, B0); PG8_MMA(0, 1, At, B1); PG8_BAR; PG8_SCHED;
            PG8_LDA(At, 0, 1); PG8_STAGE(PG8_SB(0, 0), b2, voffB); PG8_STAGE(PG8_SB(0, 1), b2 + hstep, voffB); PG8_STAGE(PG8_SA(0, 0), a2, voffA);
            PG8_WAIT_V(8); PG8_WAIT_L(0); PG8_BAR; PG8_MMA(1, 0, At, B0); PG8_MMA(1, 1, At, B1); PG8_BAR; PG8_SCHED;
            PG8_LDB(B0, 1, 0); PG8_LDB(B1, 1, 1); PG8_SCHED; PG8_LDA(At, 1, 0); PG8_STAGE(PG8_SA(0, 1), a2 + hsA, voffA);
            PG8_WAIT_V(8); PG8_WAIT_L(0); PG8_BAR; PG8_MMA(0, 0, At, B0); PG8_MMA(0, 1, At, B1); PG8_BAR; PG8_SCHED;
            PG8_LDA(At, 1, 1); PG8_STAGE(PG8_SB(1, 0), b3, voffB); PG8_STAGE(PG8_SB(1, 1), b3 + hstep, voffB); PG8_STAGE(PG8_SA(1, 0), a3, voffA);
            PG8_WAIT_V(8); PG8_WAIT_L(0); PG8_BAR; PG8_MMA(1, 0, At, B0); PG8_MMA(1, 1, At, B1); PG8_BAR; PG8_SCHED;
            } else {
            PG8_LDB(B0, 0, 0); PG8_SCHED; PG8_LDA(At, 0, 0); PG8_STAGE(PG8_SA(1, 1), a1 + hsA, voffA);
            PG8_WAIT_L(8); PG8_BAR; PG8_WAIT_L(0); PG8_MMA(0, 0, At, B0); PG8_BAR; PG8_SCHED;
            PG8_LDB(B1, 0, 1); PG8_STAGE(PG8_SB(0, 0), b2, voffB);
            PG8_BAR; PG8_WAIT_L(0); PG8_MMA(0, 1, At, B1); PG8_BAR;
            PG8_LDA(At, 0, 1); PG8_STAGE(PG8_SA(0, 0), a2, voffA);
            PG8_BAR; PG8_WAIT_L(0); PG8_MMA(1, 0, At, B0); PG8_BAR; PG8_SCHED;
            PG8_STAGE(PG8_SB(0, 1), b2 + hstep, voffB);
            PG8_WAIT_V(6); PG8_BAR; PG8_MMA(1, 1, At, B1); PG8_BAR;
            PG8_LDB(B0, 1, 0); PG8_SCHED; PG8_LDA(At, 1, 0); PG8_STAGE(PG8_SA(0, 1), a2 + hsA, voffA);
            PG8_WAIT_L(8); PG8_BAR; PG8_WAIT_L(0); PG8_MMA(0, 0, At, B0); PG8_BAR; PG8_SCHED;
            PG8_LDB(B1, 1, 1); PG8_STAGE(PG8_SB(1, 0), b3, voffB);
            PG8_BAR; PG8_WAIT_L(0); PG8_MMA(0, 1, At, B1); PG8_BAR;
            PG8_LDA(At, 1, 1); PG8_STAGE(PG8_SA(1, 0), a3, voffA);
            PG8_BAR; PG8_WAIT_L(0); PG8_MMA(1, 0, At, B0); PG8_BAR; PG8_SCHED;
            PG8_STAGE(PG8_SB(1, 1), b3 + hstep, voffB);
            PG8_WAIT_V(6); PG8_BAR; PG8_MMA(1, 1, At, B1); PG8_BAR;
            }
        }
        if constexpr (ALIGN_EPI) { if (wr == 0) PG8_BAR; }
        if constexpr (!Epi::AFTER_DRAIN) { E(acc, cur, wr, wc, fr, fq); S.done(cur); }
        if (!has_next) break;
#pragma unroll
        for (int a = 0; a < 2; ++a)
#pragma unroll
            for (int b = 0; b < 2; ++b)
#pragma unroll
                for (int m = 0; m < 4; ++m)
#pragma unroll
                    for (int n = 0; n < 2; ++n) acc[a][b][m][n] = (f32x4){0.f, 0.f, 0.f, 0.f};
        cur = nxt; cA = nA; cB = nB; ++ui;
        if constexpr (ALIGN_EPI) { if (wr == 1) PG8_BAR; }
    }
    PG8_WAIT_V(0);
    if constexpr (!ALIGN_EPI) { if (wr == 0) PG8_BAR; }
    PG8_BAR;
    if constexpr (Epi::AFTER_DRAIN) { E.fused(acc, cur, wr, wc, fr, fq, lds, wid, lane); S.done(cur); }
#undef PG8_SA
#undef PG8_SB
#undef PG8_STAGE
#undef PG8_LDA
#undef PG8_LDB
#undef PG8_MMA
#undef PG8_WAIT_V
#undef PG8_WAIT_L
#undef PG8_BAR
#undef PG8_SCHED
}
}

struct Frame {
    LAS unsigned char* lds;
    int tid, lane, wave, G;
    const float* in[24];
    float* out;
    bf16_t *Wqkv, *Wo, *Wup, *Wdn, *Wgin, *Wgo;
    bf16_t *XN, *OB, *YB;
    bf16_t *R1;
    float *LA, *SSQ, *ropec, *ropes;
};
__device__ __forceinline__ float wave_sum(float v) {
#pragma unroll
    for (int o = 1; o < 64; o <<= 1) v += __shfl_xor(v, o);
    return v;
}
__device__ __forceinline__ float wave_max(float v) {
#pragma unroll
    for (int o = 1; o < 64; o <<= 1) v = fmaxf(v, __shfl_xor(v, o));
    return v;
}
#define LDS_WAIT() asm volatile("s_waitcnt lgkmcnt(0)" ::: "memory")


#define GAS __attribute__((address_space(1)))
#define RLX_AGENT __ATOMIC_RELAXED, __HIP_MEMORY_SCOPE_AGENT
#define XB_TMO      128
#define XB_XCNT(j)  (256  + 64 * (j))
#define XB_XSUB(j)  (1280 + 64 * (j))
#define XB_XGEN(j)  (2304 + 64 * (j))
#define XB_TOP      3328
#define XB_TOPGEN   3392
#define XCD_BAR_WORDS 3456
#define XB_SPIN_CAP (1u << 18)

__device__ __forceinline__ unsigned xb_ld(unsigned* p)              { return __hip_atomic_load(p, __ATOMIC_RELAXED, __HIP_MEMORY_SCOPE_AGENT); }
__device__ __forceinline__ unsigned xb_add(unsigned* p, unsigned v) { return __hip_atomic_fetch_add(p, v, __ATOMIC_RELAXED, __HIP_MEMORY_SCOPE_AGENT); }
__device__ __forceinline__ unsigned xb_xcc_id() { return (unsigned)__builtin_amdgcn_s_getreg((3 << 11) | 20) & 0xFu; }
#define XB_SPIN(cond, bar) do { unsigned _sp = 0; while (cond) { __builtin_amdgcn_s_sleep(1); \
    if ((++_sp & 255u) == 0u) { if (xb_ld(&(bar)[XB_TMO])) break; if (_sp > XB_SPIN_CAP) { atomicAdd(&(bar)[XB_TMO], 1u); break; } } } } while (0)

struct XcdBarrier {
    unsigned* bar; unsigned x;
    volatile LAS unsigned* st;
};

__device__ __forceinline__ XcdBarrier xcd_barrier_post(unsigned* bar, volatile LAS unsigned* st) {
    XcdBarrier b; b.bar = bar; b.x = xb_xcc_id(); b.st = st;
    if (threadIdx.x == 0) (void)xb_add(&bar[XB_XCNT(b.x)], 1u);
    return b;
}
__device__ __forceinline__ void xcd_barrier_complete(unsigned* bar, unsigned x, unsigned& nloc, unsigned& nx) {
    const unsigned G = gridDim.x * gridDim.y * gridDim.z;
    unsigned sum, cnt, mine, sp = 0u;
    for (;;) {
        sum = 0u; cnt = 0u; mine = 0u;
#pragma unroll
        for (unsigned j = 0; j < 16; ++j) { const unsigned c = xb_ld(&bar[XB_XCNT(j)]); sum += c; cnt += (c > 0u) ? 1u : 0u; mine = (j == x) ? c : mine; }
        if (sum == G) break;
        __builtin_amdgcn_s_sleep(1);
        if ((++sp & 255u) == 0u) { if (xb_ld(&bar[XB_TMO])) break; if (sp > XB_SPIN_CAP) { atomicAdd(&bar[XB_TMO], 1u); break; } }
    }
    nloc = mine > 0u ? mine : 1u; nx = cnt > 0u ? cnt : 1u;
}

__device__ __forceinline__ void xcd_barrier(const XcdBarrier& b) {
    asm volatile("s_waitcnt vmcnt(0)" ::: "memory");
    __syncthreads();
    if (threadIdx.x == 0) {
        unsigned* bar = b.bar;
        __builtin_amdgcn_s_waitcnt(0);
        unsigned nloc = b.st[0], nx = b.st[1];
        if (nloc == 0u) { xcd_barrier_complete(bar, b.x, nloc, nx); b.st[0] = nloc; b.st[1] = nx; }
        const unsigned old = xb_add(&bar[XB_XSUB(b.x)], 1u);
        const unsigned gen = old / nloc;
        if (old + 1u == (gen + 1u) * nloc) {
            __builtin_amdgcn_fence(__ATOMIC_RELEASE, "agent");
            asm volatile("s_waitcnt vmcnt(0)" ::: "memory");
            const unsigned og = xb_add(&bar[XB_TOP], 1u);
            const unsigned tg = og / nx;
            if (og + 1u == (tg + 1u) * nx) xb_add(&bar[XB_TOPGEN], 1u);
            else XB_SPIN(xb_ld(&bar[XB_TOPGEN]) == tg, bar);
            __builtin_amdgcn_fence(__ATOMIC_ACQUIRE, "agent");
            xb_add(&bar[XB_XGEN(b.x)], 1u);
            asm volatile("s_waitcnt vmcnt(0)" ::: "memory");
        } else {
            XB_SPIN(xb_ld(&bar[XB_XGEN(b.x)]) == gen, bar);
            __builtin_amdgcn_fence(__ATOMIC_ACQUIRE, "agent");
            asm volatile("s_waitcnt vmcnt(0)" ::: "memory");
        }
    }
    __syncthreads();
}
__device__ __forceinline__ void p0_transpose_item(const float* W, int K, int N, bf16_t* WT, int up, LAS float* scr, int item, int lane) {
    const int nblk = N / 32, kb = item / nblk, nb = item % nblk, k0 = 64 * kb, n0 = 32 * nb;
#pragma unroll 16
    for (int i = 0; i < 32; ++i) { const int kk = 2 * i + (lane >> 5); scr[kk * 33 + (lane & 31)] = W[(size_t)(k0 + kk) * N + n0 + (lane & 31)]; }
    LDS_WAIT(); asm volatile("" ::: "memory");
    int r0 = n0;
    if (up) { const int hi = n0 >= FF, c = n0 - hi * FF; r0 = 256 * (c >> 7) + 128 * hi + (c & 127); }
    const int c = lane & 7;
#pragma unroll
    for (int j = 0; j < 4; ++j) { const int n = (lane >> 3) + 8 * j; const LAS float* s = scr + (8 * c) * 33 + n;
        u32x4 o; o.x = cvt_pk_bf16(s[0 * 33], s[1 * 33]); o.y = cvt_pk_bf16(s[2 * 33], s[3 * 33]); o.z = cvt_pk_bf16(s[4 * 33], s[5 * 33]); o.w = cvt_pk_bf16(s[6 * 33], s[7 * 33]);
        *(u32x4*)(WT + (size_t)(r0 + n) * K + k0 + 8 * c) = o; }
    LDS_WAIT(); asm volatile("" ::: "memory");
}
__device__ __forceinline__ void p0_prologue(const Frame& F) {
    LAS float* scr = (LAS float*)(F.lds + F.wave * 16384);
    const int gw = blockIdx.x * 8 + F.wave, NGW = F.G * 8;
    constexpr int I_QKV = 16 * 40, I_O = 16 * 32, I_GIN = 16 * 96, I_UP = 16 * 176, I_DN = 44 * 32;
    constexpr int NITEMS = I_QKV + 2 * I_O + I_GIN + 2 * I_UP + 2 * I_DN;
    const int gt = blockIdx.x * 512 + F.tid, NGT = F.G * 512;
#pragma unroll 1
    for (int pass = 0; pass < 2; ++pass) {
    if ((pass ^ (int)(blockIdx.x & 1)) == 0) {
    for (int it = gw; it < NITEMS; it += NGW) {
        int r = it;
        if (r < I_QKV) { p0_transpose_item(F.in[6], DM, NQKV, F.Wqkv, 0, scr, r, F.lane); continue; } r -= I_QKV;
        if (r < I_O) { p0_transpose_item(F.in[9], DM, DM, F.Wo, 0, scr, r, F.lane); continue; } r -= I_O;
        if (r < I_O) { p0_transpose_item(F.in[15], DM, DM, F.Wgo, 0, scr, r, F.lane); continue; } r -= I_O;
        if (r < I_GIN) { p0_transpose_item(F.in[10], DM, NPROJ, F.Wgin, 0, scr, r, F.lane); continue; } r -= I_GIN;
        if (r < 2 * I_UP) { const int l = r / I_UP; p0_transpose_item(F.in[16] + (size_t)l * DM * NUP, DM, NUP, F.Wup + (size_t)l * NUP * DM, 1, scr, r % I_UP, F.lane); continue; } r -= 2 * I_UP;
        { const int l = r / I_DN; p0_transpose_item(F.in[19] + (size_t)l * FF * DM, FF, DM, F.Wdn + (size_t)l * DM * FF, 0, scr, r % I_DN, F.lane); }
    }
    } else {
    for (int idx0 = gt; idx0 < (MP + NS) * 128; idx0 += 4 * NGT) { f32x4 a[4], c[4];
#pragma unroll
        for (int u = 0; u < 4; ++u) { const int idx = idx0 + u * NGT; if (idx < (MP + NS) * 128) { const int i = idx >> 7, cc = (idx & 127) * 8;
            const float* xp = (i < MP ? F.in[0] + (size_t)i * DM : F.in[1] + (size_t)(i - MP) * DM) + cc; a[u] = *(const f32x4*)xp; c[u] = *(const f32x4*)(xp + 4); } }
#pragma unroll
        for (int u = 0; u < 4; ++u) { const int idx = idx0 + u * NGT; if (idx < (MP + NS) * 128) { const int i = idx >> 7, cc = (idx & 127) * 8, r = i < MP ? i : SROW + (i - MP);
            u32x4 o; o.x = cvt_pk_bf16(a[u][0], a[u][1]); o.y = cvt_pk_bf16(a[u][2], a[u][3]); o.z = cvt_pk_bf16(c[u][0], c[u][1]); o.w = cvt_pk_bf16(c[u][2], c[u][3]);
            *(u32x4*)(F.XN + (size_t)r * DM + cc) = o; } }
    }
    }
    }
    for (int idx = gt; idx < 512 * 128; idx += NGT) { const int n = idx >> 7, k0 = (idx & 127) * 8; float s[8];
#pragma unroll
        for (int e = 0; e < 8; ++e) s[e] = 0.f;
        for (int r = 0; r < 16; ++r) { const float w2 = F.in[12][r * 512 + n];
#pragma unroll
            for (int e = 0; e < 8; ++e) s[e] += F.in[11][(k0 + e) * 16 + r] * w2; }
        u32x4 o; o.x = cvt_pk_bf16(s[0], s[1]); o.y = cvt_pk_bf16(s[2], s[3]); o.z = cvt_pk_bf16(s[4], s[5]); o.w = cvt_pk_bf16(s[6], s[7]);
        *(u32x4*)(F.Wgin + (size_t)(NPROJ + n) * DM + k0) = o; }
    for (int idx = gt; idx < 2049 * 32; idx += NGT) { const int p = idx >> 5, i = idx & 31;
        const float inv = (float)(1.0 / pow(10000.0, (double)i / 32.0)); const float pos = p < 2048 ? (float)p : 16384.f; const float ang = pos * inv;
        F.ropec[idx] = (float)cos((double)ang); F.ropes[idx] = (float)sin((double)ang); }
}

__device__ __forceinline__ void ln_phase(const Frame& F, const float* g, const float* b, bool final) {
    const int gw = blockIdx.x * 8 + F.wave, NGW = F.G * 8, lane = F.lane;
    f32x4 gv[4], bv[4];
#pragma unroll
    for (int j = 0; j < 2; ++j) { gv[2 * j] = *(const f32x4*)(g + 8 * lane + 512 * j); gv[2 * j + 1] = *(const f32x4*)(g + 8 * lane + 512 * j + 4); bv[2 * j] = *(const f32x4*)(b + 8 * lane + 512 * j); bv[2 * j + 1] = *(const f32x4*)(b + 8 * lane + 512 * j + 4); }
    for (int i = 2 * gw; i < MP + NS; i += 2 * NGW) {
        u32x4 raw[2][2]; int rr[2];
#pragma unroll
        for (int q = 0; q < 2; ++q) { const int ii = i + q; rr[q] = ii < MP ? ii : SROW + (ii - MP);
            const bf16_t* yp = F.YB + (size_t)rr[q] * DM + 8 * lane; raw[q][0] = *(const u32x4*)yp; raw[q][1] = *(const u32x4*)(yp + 512); }
        f32x4 v[2][4]; float s[2] = {0.f, 0.f};
#pragma unroll
        for (int q = 0; q < 2; ++q)
#pragma unroll
            for (int j = 0; j < 2; ++j) { const u32x4 rw = raw[q][j]; v[q][2 * j] = (f32x4){bflo(rw[0]), bfhi(rw[0]), bflo(rw[1]), bfhi(rw[1])}; v[q][2 * j + 1] = (f32x4){bflo(rw[2]), bfhi(rw[2]), bflo(rw[3]), bfhi(rw[3])}; }
#pragma unroll
        for (int q = 0; q < 2; ++q)
#pragma unroll
            for (int j = 0; j < 4; ++j) s[q] += (v[q][j][0] + v[q][j][1]) + (v[q][j][2] + v[q][j][3]);
#pragma unroll
        for (int o = 1; o < 64; o <<= 1) { s[0] += __shfl_xor(s[0], o); s[1] += __shfl_xor(s[1], o); }
        float s2[2] = {0.f, 0.f};
#pragma unroll
        for (int q = 0; q < 2; ++q) { const float mean = s[q] * (1.f / DM);
#pragma unroll
            for (int j = 0; j < 4; ++j) { v[q][j] = v[q][j] - mean; s2[q] += (v[q][j][0] * v[q][j][0] + v[q][j][1] * v[q][j][1]) + (v[q][j][2] * v[q][j][2] + v[q][j][3] * v[q][j][3]); } }
#pragma unroll
        for (int o = 1; o < 64; o <<= 1) { s2[0] += __shfl_xor(s2[0], o); s2[1] += __shfl_xor(s2[1], o); }
#pragma unroll
        for (int q = 0; q < 2; ++q) { const float rstd = 1.f / sqrtf(s2[q] * (1.f / DM) + LN_EPS);
            f32x4 o[4];
#pragma unroll
            for (int j = 0; j < 4; ++j) o[j] = v[q][j] * rstd * gv[j] + bv[j];
            if (final) { float* row = F.out + (size_t)(i + q) * DM + 8 * lane;
                *(f32x4*)row = o[0]; *(f32x4*)(row + 4) = o[1]; *(f32x4*)(row + 512) = o[2]; *(f32x4*)(row + 516) = o[3]; }
            else { bf16_t* xr = F.XN + (size_t)rr[q] * DM + 8 * lane;
                *(u32x4*)xr = (u32x4){cvt_pk_bf16(o[0][0], o[0][1]), cvt_pk_bf16(o[0][2], o[0][3]), cvt_pk_bf16(o[1][0], o[1][1]), cvt_pk_bf16(o[1][2], o[1][3])};
                *(u32x4*)(xr + 512) = (u32x4){cvt_pk_bf16(o[2][0], o[2][1]), cvt_pk_bf16(o[2][2], o[2][3]), cvt_pk_bf16(o[3][0], o[3][1]), cvt_pk_bf16(o[3][2], o[3][3])}; } }
    }
}

__device__ __forceinline__ void attn_prompt_unit(const Frame& F, int b, int kvh, int qb) {
    LAS bf16_t* Ks = (LAS bf16_t*)F.lds;
    LAS bf16_t* Vt = (LAS bf16_t*)(F.lds + 36864);
    const int tid = F.tid, lane = F.lane, w = F.wave, fr = lane & 15, g = lane >> 4;
    const bf16_t* QKV = F.R1; const bool last = (qb == 15);
#pragma unroll
    for (int rep = 0; rep < 2; ++rep) {
        const int idx = tid + 512 * rep, s = idx >> 2, d0 = 8 * (idx & 3), tk = qb * 128 - 128 + s;
        u32x4 o0 = {0u, 0u, 0u, 0u}, o1 = {0u, 0u, 0u, 0u};
        if (tk >= 0) {
            const bf16_t* kp = QKV + (size_t)(b * SEQ + tk) * NQKV + 1024 + kvh * 64 + d0;
            const u32x4 k0 = *(const u32x4*)kp, k1 = *(const u32x4*)(kp + 32);
            const float* cp = F.ropec + tk * 32 + d0; const float* sp = F.ropes + tk * 32 + d0;
            const f32x4 c0 = *(const f32x4*)cp, c1 = *(const f32x4*)(cp + 4), s0 = *(const f32x4*)sp, s1 = *(const f32x4*)(sp + 4);
            float r0[8], r1[8];
#pragma unroll
            for (int e = 0; e < 4; ++e) {
                const float xa = bflo(k0[e]), xb = bfhi(k0[e]), ya = bflo(k1[e]), yb = bfhi(k1[e]);
                const float ca = e < 2 ? c0[2 * e] : c1[2 * e - 4], cb = e < 2 ? c0[2 * e + 1] : c1[2 * e - 3];
                const float sa = e < 2 ? s0[2 * e] : s1[2 * e - 4], sb = e < 2 ? s0[2 * e + 1] : s1[2 * e - 3];
                r0[2 * e] = xa * ca - ya * sa; r0[2 * e + 1] = xb * cb - yb * sb; r1[2 * e] = ya * ca + xa * sa; r1[2 * e + 1] = yb * cb + xb * sb;
            }
            o0 = (u32x4){cvt_pk_bf16(r0[0], r0[1]), cvt_pk_bf16(r0[2], r0[3]), cvt_pk_bf16(r0[4], r0[5]), cvt_pk_bf16(r0[6], r0[7])};
            o1 = (u32x4){cvt_pk_bf16(r1[0], r1[1]), cvt_pk_bf16(r1[2], r1[3]), cvt_pk_bf16(r1[4], r1[5]), cvt_pk_bf16(r1[6], r1[7])};
            if (last && s >= 128) { float* ko = F.out + O_KP + ((size_t)(b * 128 + s - 128) * 2 + kvh) * 64 + d0;
                *(f32x4*)ko = (f32x4){r0[0], r0[1], r0[2], r0[3]}; *(f32x4*)(ko + 4) = (f32x4){r0[4], r0[5], r0[6], r0[7]};
                *(f32x4*)(ko + 32) = (f32x4){r1[0], r1[1], r1[2], r1[3]}; *(f32x4*)(ko + 36) = (f32x4){r1[4], r1[5], r1[6], r1[7]}; }
        }
        *(LAS u32x4*)(Ks + s * 72 + d0) = o0; *(LAS u32x4*)(Ks + s * 72 + 32 + d0) = o1;
    }
#pragma unroll
    for (int rep = 0; rep < 2; ++rep) {
        const int dp = lane & 31, kq = (lane >> 5) + 2 * w + 16 * rep;
        unsigned vv[8];
#pragma unroll
        for (int i = 0; i < 8; ++i) { const int s = 8 * kq + i, tk = qb * 128 - 128 + s; vv[i] = 0u;
            if (tk >= 0) { vv[i] = *(const unsigned*)(QKV + (size_t)(b * SEQ + tk) * NQKV + 1152 + kvh * 64 + 2 * dp);
                if (last && s >= 128) *(f32x2*)(F.out + O_VP + ((size_t)(b * 128 + s - 128) * 2 + kvh) * 64 + 2 * dp) = (f32x2){bflo(vv[i]), bfhi(vv[i])}; } }
        u32x4 lo, hi;
#pragma unroll
        for (int i = 0; i < 4; ++i) { lo[i] = (vv[2 * i] & 0xffffu) | (vv[2 * i + 1] << 16); hi[i] = (vv[2 * i] >> 16) | (vv[2 * i + 1] & 0xffff0000u); }
        *(LAS u32x4*)(Vt + (2 * dp) * 272 + 8 * kq) = lo; *(LAS u32x4*)(Vt + (2 * dp + 1) * 272 + 8 * kq) = hi;
    }
    __syncthreads();
    constexpr float QSC = 0.125f * 1.4426950408889634f;
    const int h = kvh * 8 + w; const float sink = F.in[8][h] * 1.4426950408889634f;
    u32x4 nq0, nq1; f32x4 nc0, nc1, ns0, ns1;
#define ATT_QLOAD(qg_) do { const int pos_ = qb * 128 + 16 * (qg_) + fr; const bf16_t* qp = QKV + (size_t)(b * SEQ + pos_) * NQKV + h * 64 + 8 * g; nq0 = *(const u32x4*)qp; nq1 = *(const u32x4*)(qp + 32); \
        const float* cp = F.ropec + pos_ * 32 + 8 * g; const float* sp = F.ropes + pos_ * 32 + 8 * g; nc0 = *(const f32x4*)cp; nc1 = *(const f32x4*)(cp + 4); ns0 = *(const f32x4*)sp; ns1 = *(const f32x4*)(sp + 4); } while (0)
    ATT_QLOAD(0);
    for (int qg = 0; qg < 8; ++qg) {
        const int i = 16 * qg + fr, pos = qb * 128 + i; const size_t rq = (size_t)(b * SEQ + pos);
        bf16x8 Bq0, Bq1;
        { const u32x4 q0 = nq0, q1 = nq1; const f32x4 c0 = nc0, c1 = nc1, s0 = ns0, s1 = ns1;
            if (qg < 7) ATT_QLOAD(qg + 1);
            float r0[8], r1[8];
#pragma unroll
            for (int e = 0; e < 4; ++e) {
                const float xa = bflo(q0[e]), xb = bfhi(q0[e]), ya = bflo(q1[e]), yb = bfhi(q1[e]);
                const float ca = e < 2 ? c0[2 * e] : c1[2 * e - 4], cb = e < 2 ? c0[2 * e + 1] : c1[2 * e - 3];
                const float sa = e < 2 ? s0[2 * e] : s1[2 * e - 4], sb = e < 2 ? s0[2 * e + 1] : s1[2 * e - 3];
                r0[2 * e] = (xa * ca - ya * sa) * QSC; r0[2 * e + 1] = (xb * cb - yb * sb) * QSC; r1[2 * e] = (ya * ca + xa * sa) * QSC; r1[2 * e + 1] = (yb * cb + xb * sb) * QSC;
            }
            Bq0 = mk8(cvt_pk_bf16(r0[0], r0[1]), cvt_pk_bf16(r0[2], r0[3]), cvt_pk_bf16(r0[4], r0[5]), cvt_pk_bf16(r0[6], r0[7]));
            Bq1 = mk8(cvt_pk_bf16(r1[0], r1[1]), cvt_pk_bf16(r1[2], r1[3]), cvt_pk_bf16(r1[4], r1[5]), cvt_pk_bf16(r1[6], r1[7])); }
        f32x4 sc[9]; float mx = -1e30f;
#pragma unroll
        for (int tt = 0; tt < 9; ++tt) {
            const LAS bf16_t* kr = Ks + ((qg + tt) * 16 + fr) * 72 + 8 * g;
            f32x4 a = {0.f, 0.f, 0.f, 0.f};
            a = mfma16(*(const LAS bf16x8*)kr, Bq0, a); a = mfma16(*(const LAS bf16x8*)(kr + 32), Bq1, a);
            if (tt == 0) {
#pragma unroll
                for (int e = 0; e < 4; ++e) a[e] = (4 * g + e - fr >= 1) ? a[e] : -1e30f; }
            if (tt == 8) {
#pragma unroll
                for (int e = 0; e < 4; ++e) a[e] = (4 * g + e - fr <= 0) ? a[e] : -1e30f; }
            if (qb == 0 && qg + tt < 8) a = (f32x4){-1e30f, -1e30f, -1e30f, -1e30f};
            mx = fmaxf(fmaxf(mx, fmaxf(a[0], a[1])), fmaxf(a[2], a[3]));
            sc[tt] = a;
        }
        mx = fmaxf(mx, __shfl_xor(mx, 16)); mx = fmaxf(mx, __shfl_xor(mx, 32)); mx = fmaxf(mx, sink);
        float sum = 0.f;
#pragma unroll
        for (int tt = 0; tt < 9; ++tt)
#pragma unroll
            for (int e = 0; e < 4; ++e) { const float p = __builtin_amdgcn_exp2f(sc[tt][e] - mx); sc[tt][e] = p; sum += p; }
        sum += __shfl_xor(sum, 16); sum += __shfl_xor(sum, 32);
        const float inv = 1.f / (sum + __builtin_amdgcn_exp2f(sink - mx));
        bf16x8 P[5];
#pragma unroll
        for (int ks = 0; ks < 5; ++ks) {
            const f32x4 lo = sc[2 * ks]; f32x4 hi = {0.f, 0.f, 0.f, 0.f}; if (2 * ks + 1 < 9) hi = sc[(2 * ks + 1) < 9 ? 2 * ks + 1 : 8];
            P[ks] = mk8(cvt_pk_bf16(lo[0], lo[1]), cvt_pk_bf16(lo[2], lo[3]), cvt_pk_bf16(hi[0], hi[1]), cvt_pk_bf16(hi[2], hi[3]));
        }
        bf16_t* orow = F.XN + rq * DM + h * 64 + 4 * g;
#pragma unroll
        for (int nt = 0; nt < 4; ++nt) {
            const LAS bf16_t* vr = Vt + (16 * nt + fr) * 272 + 4 * g;
            f32x4 o = {0.f, 0.f, 0.f, 0.f};
#pragma unroll
            for (int ks = 0; ks < 5; ++ks) { const int k0 = qg + 2 * ks, k1 = (k0 + 1) < 16 ? (k0 + 1) : 15;
                const u32x2 lo = *(const LAS u32x2*)(vr + k0 * 16), hi = *(const LAS u32x2*)(vr + k1 * 16);
                o = mfma16(mk8(lo.x, lo.y, hi.x, hi.y), P[ks], o); }
            u32x2 wv; wv.x = cvt_pk_bf16(o[0] * inv, o[1] * inv); wv.y = cvt_pk_bf16(o[2] * inv, o[3] * inv);
            *(u32x2*)(orow + 16 * nt) = wv;
        }
    }
#undef ATT_QLOAD
    __syncthreads();
}
__device__ __forceinline__ void attn_sample_unit(const Frame& F, int b) {
    LAS bf16_t* Kc = (LAS bf16_t*)F.lds;
    LAS bf16_t* Vc = (LAS bf16_t*)(F.lds + 34816);
    LAS float* qs = (LAS float*)(F.lds + 69632);
    LAS float* ps = (LAS float*)(F.lds + 73728);
    const int tid = F.tid, lane = F.lane, w = F.wave;
    const float* ck = F.in[2] + (size_t)b * 128 * 128; const float* cv = F.in[3] + (size_t)b * 128 * 128;
    float* nk = F.out + O_KS + (size_t)b * 128 * 128; float* nv = F.out + O_VS + (size_t)b * 128 * 128;
#pragma unroll
    for (int half = 0; half < 2; ++half) { f32x4 kk[4], vv[4];
#pragma unroll
        for (int it = 0; it < 4; ++it) { const int idx = tid + 512 * (4 * half + it); if (idx < 127 * 32) { const int s = 1 + (idx >> 5), c4 = 4 * (idx & 31); kk[it] = *(const f32x4*)(ck + s * 128 + c4); vv[it] = *(const f32x4*)(cv + s * 128 + c4); } }
#pragma unroll
        for (int it = 0; it < 4; ++it) { const int idx = tid + 512 * (4 * half + it); if (idx < 127 * 32) { const int s = 1 + (idx >> 5), c4 = 4 * (idx & 31);
            *(f32x4*)(nk + (s - 1) * 128 + c4) = kk[it]; *(f32x4*)(nv + (s - 1) * 128 + c4) = vv[it];
            *(LAS u32x2*)(Kc + (s - 1) * 136 + c4) = (u32x2){cvt_pk_bf16(kk[it][0], kk[it][1]), cvt_pk_bf16(kk[it][2], kk[it][3])};
            *(LAS u32x2*)(Vc + (s - 1) * 136 + c4) = (u32x2){cvt_pk_bf16(vv[it][0], vv[it][1]), cvt_pk_bf16(vv[it][2], vv[it][3])}; } } }
    const int row = SROW + b; const bf16_t* qrow = F.R1 + (size_t)row * NQKV;
    { const int h = tid >> 5, dd = tid & 31; const float q0 = bf2f(qrow[h * 64 + dd]), q1 = bf2f(qrow[h * 64 + dd + 32]);
        const float c = F.ropec[2048 * 32 + dd], s = F.ropes[2048 * 32 + dd];
        qs[h * 64 + dd] = (q0 * c - q1 * s) * 0.125f; qs[h * 64 + dd + 32] = (q1 * c + q0 * s) * 0.125f; }
    if (tid < 64) { const int kvh = tid >> 5, dd = tid & 31; const float k0 = bf2f(qrow[1024 + kvh * 64 + dd]), k1 = bf2f(qrow[1024 + kvh * 64 + dd + 32]);
        const float c = F.ropec[2048 * 32 + dd], s = F.ropes[2048 * 32 + dd]; const float r0 = k0 * c - k1 * s, r1 = k1 * c + k0 * s;
        nk[127 * 128 + kvh * 64 + dd] = r0; nk[127 * 128 + kvh * 64 + dd + 32] = r1; Kc[127 * 136 + kvh * 64 + dd] = f2bf(r0); Kc[127 * 136 + kvh * 64 + dd + 32] = f2bf(r1); }
    else if (tid < 192) { const int j = tid - 64; const bf16_t vb = qrow[1152 + j]; nv[127 * 128 + j] = bf2f(vb); Vc[127 * 136 + j] = vb; }
    __syncthreads();
#pragma unroll
    for (int r = 0; r < 4; ++r) { const int idx = tid + 512 * r, h = idx >> 7, s = idx & 127, kvh = h >> 3; float dot = 0.f;
#pragma unroll
        for (int c = 0; c < 8; ++c) { const u32x4 kk = *(const LAS u32x4*)(Kc + s * 136 + kvh * 64 + 8 * c); const f32x4 qa = *(const LAS f32x4*)(qs + h * 64 + 8 * c), qb = *(const LAS f32x4*)(qs + h * 64 + 8 * c + 4);
            dot += bflo(kk[0]) * qa[0] + bfhi(kk[0]) * qa[1] + bflo(kk[1]) * qa[2] + bfhi(kk[1]) * qa[3] + bflo(kk[2]) * qb[0] + bfhi(kk[2]) * qb[1] + bflo(kk[3]) * qb[2] + bfhi(kk[3]) * qb[3]; }
        ps[h * 128 + s] = dot; }
    __syncthreads();
#pragma unroll
    for (int x = 0; x < 2; ++x) { const int hh = w + 8 * x; const float sink = F.in[8][hh];
        const float v0 = ps[hh * 128 + lane], v1 = ps[hh * 128 + 64 + lane];
        const float m = fmaxf(wave_max(fmaxf(v0, v1)), sink); const float e0 = __expf(v0 - m), e1 = __expf(v1 - m);
        const float inv = 1.f / (wave_sum(e0 + e1) + __expf(sink - m));
        ps[hh * 128 + lane] = e0 * inv; ps[hh * 128 + 64 + lane] = e1 * inv; }
    __syncthreads();
    { const int h = tid >> 5, dp = tid & 31, kvh = h >> 3; float a0 = 0.f, a1 = 0.f;
#pragma unroll 4
        for (int s4 = 0; s4 < 128; s4 += 4) { const f32x4 p = *(const LAS f32x4*)(ps + h * 128 + s4);
#pragma unroll
            for (int x = 0; x < 4; ++x) { const unsigned vv = *(const LAS unsigned*)(Vc + (s4 + x) * 136 + kvh * 64 + 2 * dp); a0 += p[x] * bflo(vv); a1 += p[x] * bfhi(vv); } }
        *(unsigned*)(F.XN + (size_t)row * DM + h * 64 + 2 * dp) = cvt_pk_bf16(a0, a1); }
    __syncthreads();
}

__device__ __forceinline__ void gla_prompt_unit(const Frame& F, int b, int h, int vs) {
    constexpr int BUFB = 67584;
    LAS float* seg = (LAS float*)(F.lds + 2 * BUFB);
    LAS float* ssl = (LAS float*)(F.lds + 2 * BUFB + 4096);
    const int lane = F.lane, w = F.wave, fr = lane & 15, g = lane >> 4, vt = w & 3, th = w >> 2;
    const bf16_t* P = F.R1; const float* LA = F.LA;
    f32x4 S[8];
#pragma unroll
    for (int i = 0; i < 8; ++i) S[i] = (f32x4){0.f, 0.f, 0.f, 0.f};
    f32x2 rla[8]; unsigned rq[8], rk[8], rv[4];
    const int vjp = lane & 31, vtq = (lane >> 5) + 2 * w;
#define GLA_LOAD(c) do { const int row0_ = b * SEQ + 64 * (c); _Pragma("unroll") for (int i = 0; i < 8; ++i) { const size_t ro = (size_t)(row0_ + 8 * w + i); \
        rla[i] = *(const f32x2*)(LA + ro * 512 + h * 128 + 2 * lane); rq[i] = *(const unsigned*)(P + ro * NPROJ + h * 128 + 2 * lane); rk[i] = *(const unsigned*)(P + ro * NPROJ + 512 + h * 128 + 2 * lane); } \
        _Pragma("unroll") for (int i = 0; i < 4; ++i) rv[i] = *(const unsigned*)(P + (size_t)(row0_ + 4 * vtq + i) * NPROJ + 1024 + h * 256 + vs * 64 + 2 * vjp); } while (0)
#define GLA_SSQ(c) do { if (w == 0) F.SSQ[(size_t)(b * SEQ + 64 * (c) + lane) * 16 + h * 4 + vs] = (ssl[lane] + ssl[64 + lane]) + (ssl[128 + lane] + ssl[192 + lane]); } while (0)
    GLA_LOAD(0);
    for (int c = 0; c < 32; ++c) {
        const int row0 = b * SEQ + 64 * c;
        LAS unsigned char* bufp = F.lds + (c & 1) * BUFB;
        LAS bf16_t* Qin = (LAS bf16_t*)bufp; LAS bf16_t* Kin = (LAS bf16_t*)(bufp + 17408); LAS bf16_t* KoT = (LAS bf16_t*)(bufp + 34816); LAS bf16_t* Vt = (LAS bf16_t*)(bufp + 53248); LAS float* dec = (LAS float*)(bufp + 66560);
        float c0[8], c1[8]; float run0 = 0.f, run1 = 0.f;
#pragma unroll
        for (int i = 0; i < 8; ++i) { run0 += rla[i].x; run1 += rla[i].y; c0[i] = run0; c1[i] = run1; }
        *(LAS f32x2*)(seg + w * 128 + 2 * lane) = (f32x2){run0, run1};
        __syncthreads();
        if (c > 0) GLA_SSQ(c - 1);
        float pre0 = 0.f, pre1 = 0.f, tot0 = 0.f, tot1 = 0.f;
#pragma unroll
        for (int x = 0; x < 8; ++x) { const f32x2 sv = *(const LAS f32x2*)(seg + x * 128 + 2 * lane); tot0 += sv.x; tot1 += sv.y; if (x < w) { pre0 += sv.x; pre1 += sv.y; } }
        { const float et0 = __expf(tot0), et1 = __expf(tot1); float ko0[8], ko1[8];
#pragma unroll
            for (int i = 0; i < 8; ++i) { const int t = 8 * w + i; const float e0 = __expf(pre0 + c0[i]), e1 = __expf(pre1 + c1[i]), i0 = __builtin_amdgcn_rcpf(e0), i1 = __builtin_amdgcn_rcpf(e1);
                const float q0 = bflo(rq[i]), q1 = bfhi(rq[i]), k0 = bflo(rk[i]) * i0, k1 = bfhi(rk[i]) * i1;
                *(LAS unsigned*)(Qin + t * 136 + 2 * lane) = cvt_pk_bf16(q0 * QS_GLA * e0, q1 * QS_GLA * e1);
                *(LAS unsigned*)(Kin + t * 136 + 2 * lane) = cvt_pk_bf16(k0, k1);
                ko0[i] = k0 * et0; ko1[i] = k1 * et1; }
            *(LAS u32x4*)(KoT + (2 * lane) * 72 + 8 * w) = (u32x4){cvt_pk_bf16(ko0[0], ko0[1]), cvt_pk_bf16(ko0[2], ko0[3]), cvt_pk_bf16(ko0[4], ko0[5]), cvt_pk_bf16(ko0[6], ko0[7])};
            *(LAS u32x4*)(KoT + (2 * lane + 1) * 72 + 8 * w) = (u32x4){cvt_pk_bf16(ko1[0], ko1[1]), cvt_pk_bf16(ko1[2], ko1[3]), cvt_pk_bf16(ko1[4], ko1[5]), cvt_pk_bf16(ko1[6], ko1[7])};
            if (w == 0) *(LAS f32x2*)(dec + 2 * lane) = (f32x2){et0, et1}; }
        { u32x2 lo, hi;
            lo.x = (rv[0] & 0xffffu) | (rv[1] << 16); lo.y = (rv[2] & 0xffffu) | (rv[3] << 16); hi.x = (rv[0] >> 16) | (rv[1] & 0xffff0000u); hi.y = (rv[2] >> 16) | (rv[3] & 0xffff0000u);
            *(LAS u32x2*)(Vt + (2 * vjp) * 72 + 4 * vtq) = lo; *(LAS u32x2*)(Vt + (2 * vjp + 1) * 72 + 4 * vtq) = hi; }
        __syncthreads();
        if (c < 31) GLA_LOAD(c + 1);
#pragma unroll
        for (int ti = 0; ti < 2; ++ti) {
            const int tt = th == 0 ? (ti == 0 ? 0 : 3) : (ti == 0 ? 1 : 2);
            f32x4 o = {0.f, 0.f, 0.f, 0.f};
            const LAS bf16_t* qrow = Qin + (tt * 16 + fr) * 136;
#pragma unroll
            for (int ks = 0; ks < 4; ++ks) {
                const bf16x8 A = mk8(cvt_pk_bf16(S[2 * ks][0], S[2 * ks][1]), cvt_pk_bf16(S[2 * ks][2], S[2 * ks][3]), cvt_pk_bf16(S[2 * ks + 1][0], S[2 * ks + 1][1]), cvt_pk_bf16(S[2 * ks + 1][2], S[2 * ks + 1][3]));
                const u32x2 blo = *(const LAS u32x2*)(qrow + (2 * ks) * 16 + 4 * g), bhi = *(const LAS u32x2*)(qrow + (2 * ks + 1) * 16 + 4 * g);
                o = mfma16(A, mk8(blo.x, blo.y, bhi.x, bhi.y), o);
            }
#pragma unroll
            for (int sp = 0; sp < 2; ++sp) {
                if (2 * sp <= tt) {
                    f32x4 at[2];
#pragma unroll
                    for (int x = 0; x < 2; ++x) { const int st = 2 * sp + x; at[x] = (f32x4){0.f, 0.f, 0.f, 0.f};
                        if (st <= tt) { const LAS bf16_t* kr = Kin + (st * 16 + fr) * 136 + 8 * g;
#pragma unroll
                            for (int ks = 0; ks < 4; ++ks) at[x] = mfma16(*(const LAS bf16x8*)(kr + 32 * ks), *(const LAS bf16x8*)(qrow + 8 * g + 32 * ks), at[x]);
                            if (st == tt) {
#pragma unroll
                                for (int e = 0; e < 4; ++e) if (4 * g + e > fr) at[x][e] = 0.f; } } }
                    const LAS bf16_t* vr = Vt + (vt * 16 + fr) * 72 + 4 * g;
                    const u32x2 alo = *(const LAS u32x2*)(vr + (2 * sp) * 16), ahi = *(const LAS u32x2*)(vr + (2 * sp + 1) * 16);
                    o = mfma16(mk8(alo.x, alo.y, ahi.x, ahi.y), mk8(cvt_pk_bf16(at[0][0], at[0][1]), cvt_pk_bf16(at[0][2], at[0][3]), cvt_pk_bf16(at[1][0], at[1][1]), cvt_pk_bf16(at[1][2], at[1][3])), o);
                }
            }
            const int t = tt * 16 + fr;
            u32x2 wv; wv.x = cvt_pk_bf16(o[0], o[1]); wv.y = cvt_pk_bf16(o[2], o[3]);
            *(u32x2*)(F.OB + (size_t)(row0 + t) * DM + h * 256 + vs * 64 + vt * 16 + 4 * g) = wv;
            float ss = (o[0] * o[0] + o[1] * o[1]) + (o[2] * o[2] + o[3] * o[3]);
            ss += __shfl_xor(ss, 16); ss += __shfl_xor(ss, 32);
            if (g == 0) ssl[vt * 64 + t] = ss;
        }
#pragma unroll
        for (int dt = 0; dt < 8; ++dt) {
            const f32x4 dv = *(const LAS f32x4*)(dec + dt * 16 + 4 * g);
            f32x4 acc = S[dt] * dv;
            const LAS bf16_t* ar = KoT + (dt * 16 + fr) * 72 + 8 * g; const LAS bf16_t* br = Vt + (vt * 16 + fr) * 72 + 8 * g;
            acc = mfma16(*(const LAS bf16x8*)ar, *(const LAS bf16x8*)br, acc); acc = mfma16(*(const LAS bf16x8*)(ar + 32), *(const LAS bf16x8*)(br + 32), acc);
            S[dt] = acc;
        }
    }
    __syncthreads();
    GLA_SSQ(31);
#undef GLA_LOAD
#undef GLA_SSQ
    if (th == 0) {
        float* so = F.out + O_GP + ((size_t)(b * 4 + h) * 128) * 256 + vs * 64 + vt * 16 + fr;
#pragma unroll
        for (int dt = 0; dt < 8; ++dt)
#pragma unroll
            for (int e = 0; e < 4; ++e) so[(size_t)(dt * 16 + 4 * g + e) * 256] = S[dt][e];
    }
    __syncthreads();
}
__device__ __forceinline__ void gla_sample_unit(const Frame& F, int b, int h) {
    LAS float* red = (LAS float*)F.lds;
    LAS float* ssr = red + 2048;
    const int tid = F.tid, lane = F.lane, w = F.wave;
    const int row = SROW + b; const bf16_t* pr = F.R1 + (size_t)row * NPROJ; const float* la = F.LA + (size_t)row * 512 + h * 128;
    const u32x2 vv = *(const u32x2*)(pr + 1024 + h * 256 + 4 * lane); const f32x4 v4 = {bflo(vv.x), bfhi(vv.x), bflo(vv.y), bfhi(vv.y)};
    const float* s0 = F.in[4] + ((size_t)(b * 4 + h) * 128) * 256 + 4 * lane; float* s1 = F.out + O_GS + ((size_t)(b * 4 + h) * 128) * 256 + 4 * lane;
    f32x4 o4 = {0.f, 0.f, 0.f, 0.f};
    f32x4 st[16];
#pragma unroll
    for (int i = 0; i < 16; ++i) st[i] = *(const f32x4*)(s0 + (size_t)(16 * w + i) * 256);
#pragma unroll
    for (int i = 0; i < 16; ++i) { const int d = 16 * w + i; const float a = __expf(la[d]), kd = bf2f(pr[512 + h * 128 + d]), qd = bf2f(pr[h * 128 + d]) * QS_GLA;
        const f32x4 s = st[i] * a + v4 * kd; *(f32x4*)(s1 + (size_t)d * 256) = s; o4 += s * qd; }
    *(LAS f32x4*)(red + w * 256 + 4 * lane) = o4;
    __syncthreads();
    float o = 0.f, ss = 0.f;
    if (tid < 256) {
#pragma unroll
        for (int x = 0; x < 8; ++x) o += red[x * 256 + tid];
        F.OB[(size_t)row * DM + h * 256 + tid] = f2bf(o); ss = o * o; }
    ss = wave_sum(ss); if (lane == 0) ssr[w] = ss;
    __syncthreads();
    if (tid == 0) *(f32x4*)(F.SSQ + (size_t)row * 16 + h * 4) = (f32x4){(ssr[0] + ssr[1]) + (ssr[2] + ssr[3]), 0.f, 0.f, 0.f};
    __syncthreads();
}
__device__ __forceinline__ void gla_norm_phase(const Frame& F) {
    const int gw = blockIdx.x * 8 + F.wave, NGW = F.G * 8, lane = F.lane, hh = lane >> 4;
    f32x4 ng[4];
#pragma unroll
    for (int j = 0; j < 4; ++j) ng[j] = *(const f32x4*)(F.in[14] + (lane & 15) * 16 + 4 * j);
    for (int i = 2 * gw; i < MP + NS; i += 2 * NGW) {
        u32x4 ov[2][2], gv[2][2]; f32x4 sq[2]; bf16_t* op[2];
#pragma unroll
        for (int q = 0; q < 2; ++q) { const int ii = i + q, r = ii < MP ? ii : SROW + (ii - MP);
            sq[q] = *(const f32x4*)(F.SSQ + (size_t)r * 16 + hh * 4);
            op[q] = F.OB + (size_t)r * DM + lane * 16; const bf16_t* gp = F.R1 + (size_t)r * NPROJ + 2048 + lane * 16;
            ov[q][0] = *(const u32x4*)op[q]; ov[q][1] = *(const u32x4*)(op[q] + 8); gv[q][0] = *(const u32x4*)gp; gv[q][1] = *(const u32x4*)(gp + 8); }
#pragma unroll
        for (int q = 0; q < 2; ++q) { const float rs = 1.f / sqrtf(((sq[q][0] + sq[q][1]) + (sq[q][2] + sq[q][3])) * (1.f / 256.f) + 1e-6f);
#pragma unroll
            for (int x = 0; x < 2; ++x) { u32x4 w;
#pragma unroll
                for (int e = 0; e < 4; ++e) { const float o0 = bflo(ov[q][x][e]), o1 = bfhi(ov[q][x][e]), g0 = bflo(gv[q][x][e]), g1 = bfhi(gv[q][x][e]);
                    const int k = 8 * x + 2 * e; const float n0 = ng[k >> 2][k & 3], n1 = ng[(k + 1) >> 2][(k + 1) & 3];
                    w[e] = cvt_pk_bf16(o0 * rs * n0 * (g0 / (1.f + __expf(-g0))), o1 * rs * n1 * (g1 / (1.f + __expf(-g1)))); }
                *(u32x4*)(op[q] + 8 * x) = w; } }
    }
}

template <class EpiS>
__device__ __forceinline__ void sample_gemm(const Frame& F, const bf16_t* A, const bf16_t* Bt, int N, int K, const EpiS& E) {
    LAS float* red = (LAS float*)F.lds;
    const int lane = F.lane, w = F.wave, fr = lane & 15, g = lane >> 4, kw = K >> 3, npieces = (N >> 5) * 8;
    for (int p = blockIdx.x; p < npieces; p += F.G) {
        const int rg = p & 7, cgp = p >> 3;
        const bf16_t* ap = A + (size_t)(rg * 16 + fr) * K + w * kw + 8 * g;
        const bf16_t* b0 = Bt + (size_t)(cgp * 32 + fr) * K + w * kw + 8 * g; const bf16_t* b1 = b0 + (size_t)16 * K;
        f32x4 c0 = {0.f, 0.f, 0.f, 0.f}, c1 = {0.f, 0.f, 0.f, 0.f};
#pragma unroll 4
        for (int k = 0; k < kw; k += 32) { const bf16x8 a = *(const bf16x8*)(ap + k), x0 = *(const bf16x8*)(b0 + k), x1 = *(const bf16x8*)(b1 + k);
            c0 = mfma16(x0, a, c0); c1 = mfma16(x1, a, c1); }
        *(LAS f32x4*)(red + w * 512 + fr * 32 + 4 * g) = c0; *(LAS f32x4*)(red + w * 512 + fr * 32 + 16 + 4 * g) = c1;
        __syncthreads();
        { float v = 0.f;
#pragma unroll
            for (int x = 0; x < 8; ++x) v += red[x * 512 + F.tid];
            E(rg * 16 + (F.tid >> 5), cgp * 32 + (F.tid & 31), v); }
        __syncthreads();
    }
}
struct SEpiRes { const float* res; const bf16_t* resB; bf16_t* out;
    __device__ __forceinline__ void operator()(int b, int col, float v) const { const float x = res ? res[(size_t)b * DM + col] : bf2f(resB[(size_t)b * DM + col]); out[(size_t)b * DM + col] = f2bf(ALPHA * x + v); } };
struct SEpiGlaIn { bf16_t* P; float* LA; const float* ba;
    __device__ __forceinline__ void operator()(int b, int col, float v) const {
        if (col < NPROJ) P[(size_t)(SROW + b) * NPROJ + col] = f2bf(v);
        else { const float z = v + ba[col - NPROJ]; LA[(size_t)(SROW + b) * 512 + col - NPROJ] = -(fmaxf(-z, 0.f) + log1pf(__expf(-fabsf(z)))) * 0.0625f; } } };

struct Args { const float* in[24]; float* out; unsigned char* ws; int ph_lo, ph_hi; };
constexpr int NPHASE = 16;
__global__ void __launch_bounds__(512, 2) mega_fwd(Args args) {
    extern __shared__ __attribute__((aligned(16))) unsigned char lds[];
    cg::grid_group grid = cg::this_grid();
    Frame F;
    F.lds = (LAS unsigned char*)lds;
    F.tid = threadIdx.x; F.lane = F.tid & 63; F.wave = __builtin_amdgcn_readfirstlane(F.tid >> 6); F.G = gridDim.x;
#pragma unroll
    for (int i = 0; i < 24; ++i) F.in[i] = args.in[i];
    F.out = args.out;
    unsigned char* ws = args.ws;
    F.Wqkv = (bf16_t*)(ws + WS_WQKV); F.Wo = (bf16_t*)(ws + WS_WO); F.Wup = (bf16_t*)(ws + WS_WUP); F.Wdn = (bf16_t*)(ws + WS_WDN); F.Wgin = (bf16_t*)(ws + WS_WGIN); F.Wgo = (bf16_t*)(ws + WS_WGO);
    F.XN = (bf16_t*)(ws + WS_XN) + 8 * DM; F.OB = (bf16_t*)(ws + 400 * MiB); F.YB = (bf16_t*)(ws + WS_LA);     F.R1 = (bf16_t*)(ws + WS_R1); F.LA = (float*)(ws + WS_LA); F.SSQ = (float*)(ws + WS_SSQ);
    F.ropec = (float*)(ws + WS_ROPE); F.ropes = F.ropec + 2049 * 32;
    volatile LAS unsigned* MISC = (volatile LAS unsigned*)(F.lds + LDS_BYTES - 64);
    if (F.tid < 4) MISC[F.tid] = 0u;
    __syncthreads();
    XcdBarrier xbar = xcd_barrier_post((unsigned*)(ws + 16384), MISC);
    const int lo = args.ph_lo, hi = args.ph_hi;
#ifndef PH_MASK
#define PH_MASK 0xffff
#endif
#define IN(k) (((PH_MASK >> (k)) & 1) && lo <= (k) && (k) < hi)
#define GRID_SEAM_CG() do { asm volatile("s_waitcnt vmcnt(0) lgkmcnt(0)" ::: "memory"); grid.sync(); \
        if (F.tid == 0) { __builtin_amdgcn_fence(__ATOMIC_ACQUIRE, "agent"); asm volatile("s_waitcnt vmcnt(0)" ::: "memory"); } __syncthreads(); } while (0)
#define GRID_SEAM() do { xcd_barrier(xbar); } while (0)
#ifndef PROBE_SPIN
#define PROBE_SPIN 0
#endif
#ifndef PROBE_RVR
#define PROBE_RVR 0
#endif
#ifndef PROBE_CAL
#define PROBE_CAL 0
#endif
#define PROBING (PROBE_SPIN || PROBE_RVR || PROBE_CAL)
    unsigned long long* const tsb = (unsigned long long*)(ws + 4096);
#define STAMP(k) do { if (PROBING && blockIdx.x == 0 && F.tid == 0) tsb[k] = __builtin_amdgcn_s_memrealtime(); } while (0)
#define SEAM(k) do { if (IN(k) && IN((k) + 1)) { if ((k) == 0) GRID_SEAM_CG(); else GRID_SEAM(); STAMP((k) + 1); } } while (0)
    STAMP(0);
    using pg8::Gemm; using pg8::StaticOrder;

    if (IN(0)) { p0_prologue(F); } SEAM(0);
    if (IN(1)) {
        Gemm g{F.XN, F.Wqkv, NQKV, DM, 129, 0}; StaticOrder S; S.init(129, NQKV, F.G, (int)blockIdx.x);
        pg8::EpiBf16Bias E{F.R1, NQKV, F.in[7]};
        pg8::gemm_phase<pg8::EpiBf16Bias, StaticOrder, true, true>(F.lds, g, S, E);
    } SEAM(1);
    if (IN(2)) {
        for (int u = blockIdx.x; u < 640; u += F.G) {
            if (u < 128) attn_sample_unit(F, u);
            else { const int v = u - 128; attn_prompt_unit(F, v >> 5, (v >> 4) & 1, v & 15); }
        }
    } SEAM(2);
    if (IN(3)) {
        { SEpiRes ES{F.in[1], nullptr, F.YB + (size_t)SROW * DM}; sample_gemm(F, F.XN + (size_t)SROW * DM, F.Wo, DM, DM, ES); }
        Gemm g{F.XN, F.Wo, DM, DM, 128, 0}; StaticOrder S; S.init(128, DM, F.G, (int)blockIdx.x);
        pg8::EpiRes<false> E{F.in[0], F.in[1], nullptr, F.YB};
#ifdef DBG_COPY
        (void)g; (void)S; (void)E;
        for (int idx = blockIdx.x * 512 + F.tid; idx < (MP + NS) * 128; idx += F.G * 512) { const int i = idx >> 7, c = (idx & 127) * 8; const int r = i < MP ? i : SROW + (i - MP);
            const u32x4 v = *(const u32x4*)(F.OB + (size_t)r * DM + c); float* o = F.out + (size_t)i * DM + c;
            *(f32x4*)o = (f32x4){bflo(v[0]), bfhi(v[0]), bflo(v[1]), bfhi(v[1])}; *(f32x4*)(o + 4) = (f32x4){bflo(v[2]), bfhi(v[2]), bflo(v[3]), bfhi(v[3])}; }
#else
        pg8::gemm_phase<pg8::EpiRes<false>, StaticOrder, true, true>(F.lds, g, S, E);
#endif
    } SEAM(3);
    if (IN(4)) { ln_phase(F, F.in[20], F.in[21], false); } SEAM(4);
#define FFN_PHASES(l, pb) do { \
        if (IN(pb)) { \
            Gemm g{F.XN, F.Wup + (size_t)(l) * NUP * DM, NUP, DM, 134, 1}; StaticOrder S; S.init(134, NUP, F.G, (int)blockIdx.x); \
            pg8::EpiUp E{F.R1, F.in[17] + (size_t)(l) * 3 * FF, F.in[18] + (size_t)(l) * FF, F.in[5] + (size_t)(l) * NS * 2 * FF, F.out + O_CP + (size_t)(l) * NBATCH * 2 * FF, F.out + O_CS + (size_t)(l) * NS * 2 * FF}; \
            pg8::gemm_phase<pg8::EpiUp, StaticOrder, true, true>(F.lds, g, S, E); \
        } SEAM(pb); \
        if (IN((pb) + 1)) { \
            { SEpiRes ES{nullptr, F.XN + (size_t)SROW * DM, F.YB + (size_t)SROW * DM}; sample_gemm(F, F.R1 + (size_t)SROW * FF, F.Wdn + (size_t)(l) * DM * FF, DM, FF, ES); } \
            Gemm g{F.R1, F.Wdn + (size_t)(l) * DM * FF, DM, FF, 128, 0}; StaticOrder S; S.init(128, DM, F.G, (int)blockIdx.x); \
            pg8::EpiRes<true> E{nullptr, nullptr, F.XN, F.YB}; \
            pg8::gemm_phase<pg8::EpiRes<true>, StaticOrder, true, true>(F.lds, g, S, E); \
        } SEAM((pb) + 1); \
        if (IN((pb) + 2)) { ln_phase(F, F.in[22] + (size_t)(l) * DM, F.in[23] + (size_t)(l) * DM, (l) == 1); } SEAM((pb) + 2); } while (0)
    FFN_PHASES(0, 5);
    if (IN(8)) {
        { SEpiGlaIn ES{F.R1, F.LA, F.in[13]}; sample_gemm(F, F.XN + (size_t)SROW * DM, F.Wgin, NGIN, DM, ES); }
        Gemm g{F.XN, F.Wgin, NGIN, DM, 128, 0}; StaticOrder S; S.init(128, NGIN, F.G, (int)blockIdx.x);
        pg8::EpiGlaIn E{F.R1, F.LA, F.in[13]};
        pg8::gemm_phase<pg8::EpiGlaIn, StaticOrder, true, true>(F.lds, g, S, E);
    } SEAM(8);
    if (IN(9)) {
        for (int u = blockIdx.x; u < 768; u += F.G) {
            if (u < 256) gla_prompt_unit(F, u >> 4, (u >> 2) & 3, u & 3);
            else { const int v = u - 256; gla_sample_unit(F, v >> 2, v & 3); }
        }
    } SEAM(9);
    if (IN(10)) { gla_norm_phase(F); } SEAM(10);
    if (IN(11)) {
        { SEpiRes ES{nullptr, F.XN + (size_t)SROW * DM, F.YB + (size_t)SROW * DM}; sample_gemm(F, F.OB + (size_t)SROW * DM, F.Wgo, DM, DM, ES); }
        Gemm g{F.OB, F.Wgo, DM, DM, 128, 0}; StaticOrder S; S.init(128, DM, F.G, (int)blockIdx.x);
        pg8::EpiRes<true> E{nullptr, nullptr, F.XN, F.YB};
        pg8::gemm_phase<pg8::EpiRes<true>, StaticOrder, true, true>(F.lds, g, S, E);
    } SEAM(11);
    if (IN(12)) { ln_phase(F, F.in[20] + DM, F.in[21] + DM, false); } SEAM(12);
    FFN_PHASES(1, 13);
#undef FFN_PHASES
    if (PROBING) {
        GRID_SEAM(); STAMP(16);
        if (blockIdx.x == 0 && F.tid == 0) {
            unsigned long long spin = 0, rv = 0;
            for (int k = 0; k < 16; ++k) { const unsigned long long d = tsb[k + 1] - tsb[k]; if ((PROBE_SPIN >> k) & 1) spin += d; if ((PROBE_RVR >> k) & 1) rv += d; }
            tsb[32] = spin; ((float*)(tsb + 33))[0] = 0.01f * sqrtf(1.f + (float)rv * 0.01f / 4000.f);
        }
        GRID_SEAM();
        const unsigned long long spin = tsb[32]; const float dd = 1.f + ((const float*)(tsb + 33))[0];
        for (int idx = blockIdx.x * 512 + F.tid; idx < 1441792 / 4; idx += F.G * 512) { f32x4* p = (f32x4*)(F.out + O_CS) + idx; *p = *p * dd; }
        const unsigned long long t0 = __builtin_amdgcn_s_memrealtime();
        while (__builtin_amdgcn_s_memrealtime() - t0 < spin) __builtin_amdgcn_s_sleep(8);
    }
#undef IN
#undef SEAM
}

extern "C" void kernel_launch(void* const* d_in, const int* in_sizes, int n_in, void* d_out, int out_size, void* d_ws, size_t ws_size, hipStream_t stream) {
    static int grid = 0;
    if (grid == 0) {
        if (n_in != 24 || out_size != 58900480 || ws_size < 466 * MiB) { fprintf(stderr, "kernel_launch: unexpected shapes (n_in %d out %d ws %zu)\n", n_in, out_size, ws_size); grid = -1; return; }
        int dev = 0, cus = 0, per_cu = 0;
        if (hipGetDevice(&dev) != hipSuccess || hipDeviceGetAttribute(&cus, hipDeviceAttributeMultiprocessorCount, dev) != hipSuccess) { grid = -1; return; }
        if (hipFuncSetAttribute((const void*)mega_fwd, hipFuncAttributeMaxDynamicSharedMemorySize, LDS_BYTES) != hipSuccess) { fprintf(stderr, "kernel_launch: hipFuncSetAttribute failed\n"); grid = -1; return; }
        if (hipOccupancyMaxActiveBlocksPerMultiprocessor(&per_cu, (const void*)mega_fwd, 512, LDS_BYTES) != hipSuccess || per_cu < 1) { fprintf(stderr, "kernel_launch: occupancy query says %d\n", per_cu); per_cu = 1; }
        (void)hipGetLastError();
        grid = cus * 1;
    }
    if (grid < 0) return;
    if (hipMemsetAsync((char*)d_ws + 16384, 0, 16384, stream) != hipSuccess) { fprintf(stderr, "kernel_launch: memset failed\n"); return; }
    Args a{};
    for (int i = 0; i < 24; ++i) a.in[i] = (const float*)d_in[i];
    a.out = (float*)d_out; a.ws = (unsigned char*)d_ws;
#if MK_PER_PHASE
    for (int p = 0; p < NPHASE; ++p) { a.ph_lo = p; a.ph_hi = p + 1; hipLaunchKernelGGL(mega_fwd, dim3(grid), dim3(512), LDS_BYTES, stream, a); }
#else
    a.ph_lo = 0; a.ph_hi = NPHASE;
    void* kargs[] = {&a};
    const hipError_t e = hipLaunchCooperativeKernel((const void*)mega_fwd, dim3(grid), dim3(512), kargs, LDS_BYTES, stream);
    if (e != hipSuccess) fprintf(stderr, "kernel_launch: cooperative launch failed: %s (grid %d)\n", hipGetErrorString(e), grid);
#endif
}
```
